# Optimizing an MI355X kernel written in HIP

```python
import math
import jax, jax.numpy as jnp
from jax import lax
import numpy as np

D_MODEL = 1024
BATCH = 2
SEQ = 16384
DEPTH = 2

GRID_W = 64
CTX_LEN = 256

DN_HEADS = 4
DN_HEAD_DIM = 128
DN_WIDTH = DN_HEADS * DN_HEAD_DIM
DN_CONV = 3
DN_CHUNK = 64
DN_DIRS = 2
NA_HEADS = 4
NA_HEAD_DIM = 64
NA_WIDTH = NA_HEADS * NA_HEAD_DIM
NA_WIN_H = 8
NA_WIN_W = 16
NA_QBLOCK = 128
FT_GROUPS = 4
FT_GROUP_DIM = 64
FT_WIDTH = FT_GROUPS * FT_GROUP_DIM
MIX_WIDTH = DN_WIDTH + NA_WIDTH + FT_WIDTH
IN_SPLITS = (3 * DN_WIDTH, DN_WIDTH, DN_DIRS * DN_HEADS, DN_DIRS * DN_HEADS,
             NA_WIDTH, NA_WIDTH, NA_WIDTH, FT_WIDTH)
IN_WIDTH = sum(IN_SPLITS)
D_FF = 2816
N_EXPERTS = 8
TOP_K = 2
D_FF_EXPERT = 3584
MOE_BLOCK = 256
N_DENSE = (DEPTH + 1) // 2
N_MOE = DEPTH // 2
N_MOD = 6
EPS = 1e-6

kernel_name = "hybrid_deltanet_natten_fnet_moe_dit"


def rms_norm(x, g):
    xf = x.astype(jnp.float32)
    y = xf * lax.rsqrt(jnp.mean(xf * xf, axis=-1, keepdims=True) + EPS)
    return y.astype(x.dtype) * g


def l2_norm(x):
    return x * lax.rsqrt(jnp.sum(x * x, axis=-1, keepdims=True) + EPS)


def centred_depthwise_conv(x, w):
    k_size = w.shape[0]
    pad = k_size // 2
    length = x.shape[1]
    xp = jnp.pad(x, ((0, 0), (pad, k_size - 1 - pad), (0, 0)))
    out = xp[:, :length] * w[0]
    for j in range(1, k_size):
        out = out + xp[:, j:j + length] * w[j]
    return out


def gated_delta_rule(q, k, v, g, beta, s0):
    bsz, length, heads, _ = q.shape
    dv = v.shape[-1]
    n_chunks = length // DN_CHUNK

    def to_chunks(t):
        t = t.reshape((bsz, n_chunks, DN_CHUNK, heads) + t.shape[3:])
        return jnp.moveaxis(t, (1, 3), (0, 2))

    qc, kc, vc = to_chunks(q), to_chunks(k), to_chunks(v)
    gc = jnp.cumsum(to_chunks(g), axis=-1)
    bc = to_chunks(beta)
    incl = jnp.tril(jnp.ones((DN_CHUNK, DN_CHUNK), bool))
    strict = jnp.tril(jnp.ones((DN_CHUNK, DN_CHUNK), bool), -1)
    diff = gc[..., :, None] - gc[..., None, :]
    decay = jnp.where(incl, jnp.exp(jnp.where(incl, diff, 0.0)), 0.0)
    kb = kc * bc[..., None]
    a_mat = jnp.where(strict, jnp.einsum('nbhid,nbhjd->nbhij', kb, kc) * decay, 0.0)
    eye = jnp.eye(DN_CHUNK, dtype=q.dtype)
    t_mat = lax.linalg.triangular_solve(eye + a_mat, jnp.broadcast_to(eye, a_mat.shape),
                                        left_side=True, lower=True, unit_diagonal=True)
    u = t_mat @ (vc * bc[..., None])
    w = t_mat @ (kb * jnp.exp(gc)[..., None])
    qk = jnp.einsum('nbhid,nbhjd->nbhij', qc, kc) * decay

    def step(state, inp):
        q_i, k_i, u_i, w_i, g_i, qk_i = inp
        v_new = u_i - w_i @ state
        o_i = (q_i * jnp.exp(g_i)[..., None]) @ state + qk_i @ v_new
        g_last = g_i[..., -1:]
        state = state * jnp.exp(g_last)[..., None] + jnp.einsum(
            'bhcd,bhce->bhde', k_i * jnp.exp(g_last - g_i)[..., None], v_new)
        return state, o_i

    s_fin, o = lax.scan(step, s0, (qc, kc, u, w, gc, qk))
    o = jnp.moveaxis(o, (0, 2), (1, 3)).reshape(bsz, length, heads, dv)
    return o, s_fin


def deltanet_branch(qkv, z, alpha, beta_logit, conv_w, a_log, dt_bias, norm_w, s0_fwd, s0_bwd):
    bsz, length, _ = qkv.shape
    out_dtype = qkv.dtype
    qkv = jax.nn.silu(centred_depthwise_conv(qkv, conv_w)).astype(jnp.float32)
    q, k, v = jnp.split(qkv, 3, axis=-1)
    heads = lambda t: t.reshape(bsz, length, DN_HEADS, DN_HEAD_DIM)
    q = l2_norm(heads(q)) * (DN_HEAD_DIM ** -0.5)
    k = l2_norm(heads(k))
    v = heads(v)
    a = alpha.astype(jnp.float32).reshape(bsz, length, DN_DIRS, DN_HEADS)
    g = -jnp.exp(a_log.astype(jnp.float32)) * jax.nn.softplus(a + dt_bias.astype(jnp.float32))
    beta = jax.nn.sigmoid(beta_logit.astype(jnp.float32).reshape(bsz, length, DN_DIRS, DN_HEADS))
    o_f, s_f = gated_delta_rule(q, k, v, g[:, :, 0], beta[:, :, 0], s0_fwd)
    flip = lambda t: jnp.flip(t, axis=1)
    o_b, s_b = gated_delta_rule(flip(q), flip(k), flip(v), flip(g[:, :, 1]), flip(beta[:, :, 1]), s0_bwd)
    o = o_f + flip(o_b)
    o = rms_norm(o, norm_w.astype(jnp.float32)) * jax.nn.silu(heads(z).astype(jnp.float32))
    return o.reshape(bsz, length, DN_WIDTH).astype(out_dtype), s_f, s_b


def neighbourhood_attention(q, k, v, kc, vc, rpb):
    bsz, length, heads, hd = q.shape
    rows = length // GRID_W
    kh = min(NA_WIN_H, rows)
    kw = NA_WIN_W
    n_keys = kh * kw
    pos = jnp.arange(length)
    r = pos // GRID_W
    col = pos % GRID_W
    r0 = jnp.clip(r - kh // 2, 0, rows - kh)
    c0 = jnp.clip(col - kw // 2, 0, GRID_W - kw)
    key_r = r0[:, None, None] + jnp.arange(kh)[None, :, None]
    key_c = c0[:, None, None] + jnp.arange(kw)[None, None, :]
    key_idx = (key_r * GRID_W + key_c).reshape(length, n_keys)
    off_r = jnp.broadcast_to(key_r - r[:, None, None] + NA_WIN_H - 1, (length, kh, kw)).reshape(length, n_keys)
    off_c = jnp.broadcast_to(key_c - col[:, None, None] + NA_WIN_W - 1, (length, kh, kw)).reshape(length, n_keys)
    n_blocks = length // NA_QBLOCK
    scale = hd ** -0.5

    def block(args):
        qb, idx, o_r, o_c = args
        kg = k[:, idx]
        vg = v[:, idx]
        s_loc = jnp.einsum('bqhd,bqkhd->bhqk', qb, kg) * scale + rpb[:, o_r, o_c][None]
        s_ctx = jnp.einsum('bqhd,bchd->bhqc', qb, kc) * scale
        p = jax.nn.softmax(jnp.concatenate([s_loc, s_ctx], axis=-1).astype(jnp.float32), axis=-1).astype(v.dtype)
        return (jnp.einsum('bhqk,bqkhd->bqhd', p[..., :n_keys], vg)
                + jnp.einsum('bhqc,bchd->bqhd', p[..., n_keys:], vc))

    qs = jnp.moveaxis(q.reshape(bsz, n_blocks, NA_QBLOCK, heads, hd), 1, 0)
    o = lax.map(block, (qs,
                        key_idx.reshape(n_blocks, NA_QBLOCK, n_keys),
                        off_r.reshape(n_blocks, NA_QBLOCK, n_keys),
                        off_c.reshape(n_blocks, NA_QBLOCK, n_keys)))
    return jnp.moveaxis(o, 0, 1).reshape(bsz, length, heads * hd)


def context_attention(q, k, v):
    bsz, length, heads, hd = q.shape
    s = jnp.einsum('bqhd,bkhd->bhqk', q, k) * (hd ** -0.5)
    p = jax.nn.softmax(s.astype(jnp.float32), axis=-1).astype(v.dtype)
    return jnp.einsum('bhqk,bkhd->bqhd', p, v).reshape(bsz, length, heads * hd)


def fourier_mix(u, w):
    bsz, length, _ = u.shape
    ug = u.astype(jnp.float32).reshape(bsz, length, FT_GROUPS, FT_GROUP_DIM)
    f = jnp.fft.fftn(ug, axes=(1, 3), norm="ortho").real
    return f.reshape(bsz, length, FT_WIDTH).astype(u.dtype) @ w


def token_mixers(h, hc, need_ctx, w_in, conv_w, a_log, dt_bias, dn_norm_w, q_norm, k_norm, rpb, fno_w, w_out):
    offs = [int(o) for o in np.cumsum(IN_SPLITS)[:-1]]
    qkv, z, al, be, nq, nk, nv, ft = jnp.split(h @ w_in, offs, axis=-1)
    qkv_c, z_c, al_c, be_c, nq_c, nk_c, nv_c, ft_c = jnp.split(hc @ w_in, offs, axis=-1)
    bsz = h.shape[0]
    zero = jnp.zeros((bsz, DN_HEADS, DN_HEAD_DIM, DN_HEAD_DIM), jnp.float32)
    oa_c, s_f, s_b = deltanet_branch(qkv_c, z_c, al_c, be_c, conv_w, a_log, dt_bias, dn_norm_w, zero, zero)
    oa, _, _ = deltanet_branch(qkv, z, al, be, conv_w, a_log, dt_bias, dn_norm_w, s_f, s_b)
    heads = lambda t: t.reshape(t.shape[0], t.shape[1], NA_HEADS, NA_HEAD_DIM)
    q = rms_norm(heads(nq), q_norm)
    k = rms_norm(heads(nk), k_norm)
    v = heads(nv)
    k_c = rms_norm(heads(nk_c), k_norm)
    v_c = heads(nv_c)
    ob = neighbourhood_attention(q, k, v, k_c, v_c, rpb)
    oc = fourier_mix(ft, fno_w)
    y = jnp.concatenate([oa, ob, oc], axis=-1) @ w_out
    if not need_ctx:
        return y, None
    ob_c = context_attention(rms_norm(heads(nq_c), q_norm), k_c, v_c)
    oc_c = fourier_mix(ft_c, fno_w)
    yc = jnp.concatenate([oa_c, ob_c, oc_c], axis=-1) @ w_out
    return y, yc


def swiglu(h, w1, w3, w2):
    return (jax.nn.silu(h @ w1) * (h @ w3)) @ w2


def moe_swiglu(h, w_router, w1, w3, w2):
    bsz, length, d = h.shape
    t = h.reshape(-1, d)
    n_tok = t.shape[0]
    logits = (t @ w_router).astype(jnp.float32)
    top_l, top_e = lax.top_k(logits, TOP_K)
    top_w = jax.nn.softmax(top_l, axis=-1)
    n_assign = n_tok * TOP_K
    e_flat = top_e.reshape(n_assign)
    tok_flat = jnp.arange(n_assign) // TOP_K
    w_flat = top_w.reshape(n_assign)
    order = jnp.argsort(e_flat)
    e_s, tok_s, w_s = e_flat[order], tok_flat[order], w_flat[order]
    counts = jnp.bincount(e_flat, length=N_EXPERTS)
    padded = (counts + MOE_BLOCK - 1) // MOE_BLOCK * MOE_BLOCK
    pad_end = jnp.cumsum(padded)
    pad_start = pad_end - padded
    start = jnp.cumsum(counts) - counts
    dest = pad_start[e_s] + (jnp.arange(n_assign) - start[e_s])
    n_blocks = -(-n_assign // MOE_BLOCK) + N_EXPERTS
    n_slots = n_blocks * MOE_BLOCK
    slot_tok = jnp.zeros((n_slots,), jnp.int32).at[dest].set(tok_s.astype(jnp.int32))
    slot_w = jnp.zeros((n_slots,), t.dtype).at[dest].set(w_s.astype(t.dtype))
    block_e = jnp.minimum(jnp.searchsorted(pad_end, jnp.arange(n_blocks) * MOE_BLOCK, side='right'), N_EXPERTS - 1)
    xb = t[slot_tok].reshape(n_blocks, MOE_BLOCK, d)

    def expert_block(args):
        x_blk, e = args
        return swiglu(x_blk, w1[e], w3[e], w2[e])

    yb = lax.map(expert_block, (xb, block_e)).reshape(n_slots, d)
    out = jax.ops.segment_sum(yb * slot_w[:, None], slot_tok, num_segments=n_tok)
    return out.reshape(bsz, length, d)


def channel_mixer(h, layer, ffn_w1, ffn_w3, ffn_w2, moe_router, moe_w1, moe_w3, moe_w2):
    j = layer // 2
    if layer % 2 == 0:
        return swiglu(h, ffn_w1[j], ffn_w3[j], ffn_w2[j])
    return moe_swiglu(h, moe_router[j], moe_w1[j], moe_w3[j], moe_w2[j])


def setup_inputs(seed: int = 0) -> dict:
    key = jax.random.key(seed)
    ks = jax.random.split(key, 32)
    f32 = jnp.float32
    D = D_MODEL
    nrm = lambda k, shape, s: jax.random.normal(k, shape, f32) * s
    dt = jnp.exp(jax.random.uniform(ks[11], (DEPTH, DN_DIRS, DN_HEADS), f32, math.log(1e-3), math.log(1e-1)))
    return {
        "x": nrm(ks[0], (BATCH, SEQ, D), 1.0),
        "c": nrm(ks[1], (BATCH, D), 1.0),
        "ctx": nrm(ks[2], (BATCH, CTX_LEN, D), 1.0),
        "c_ctx": nrm(ks[3], (D,), 1.0),
        "w_mod": nrm(ks[4], (DEPTH, D, N_MOD * D), D ** -0.5),
        "b_mod": nrm(ks[5], (DEPTH, N_MOD * D), 0.01),
        "g_mix": 1.0 + nrm(ks[6], (DEPTH, D), 0.05),
        "g_ffn": 1.0 + nrm(ks[7], (DEPTH, D), 0.05),
        "w_in": nrm(ks[8], (DEPTH, D, IN_WIDTH), D ** -0.5),
        "dn_conv": nrm(ks[9], (DEPTH, DN_CONV, 3 * DN_WIDTH), DN_CONV ** -0.5),
        "dn_a_log": jnp.log(jax.random.uniform(ks[10], (DEPTH, DN_DIRS, DN_HEADS), f32, 1.0, 16.0)),
        "dn_dt_bias": dt + jnp.log(-jnp.expm1(-dt)),
        "dn_norm_w": 1.0 + nrm(ks[12], (DEPTH, DN_HEAD_DIM), 0.05),
        "na_q_norm": 1.0 + nrm(ks[13], (DEPTH, NA_HEAD_DIM), 0.05),
        "na_k_norm": 1.0 + nrm(ks[14], (DEPTH, NA_HEAD_DIM), 0.05),
        "na_rpb": nrm(ks[15], (DEPTH, NA_HEADS, 2 * NA_WIN_H - 1, 2 * NA_WIN_W - 1), 0.1),
        "fno_w": nrm(ks[16], (DEPTH, FT_WIDTH, FT_WIDTH), FT_WIDTH ** -0.5),
        "w_out": nrm(ks[17], (DEPTH, MIX_WIDTH, D), MIX_WIDTH ** -0.5),
        "ffn_w1": nrm(ks[18], (N_DENSE, D, D_FF), D ** -0.5),
        "ffn_w3": nrm(ks[19], (N_DENSE, D, D_FF), D ** -0.5),
        "ffn_w2": nrm(ks[20], (N_DENSE, D_FF, D), D_FF ** -0.5),
        "moe_router": nrm(ks[21], (N_MOE, D, N_EXPERTS), D ** -0.5),
        "moe_w1": nrm(ks[22], (N_MOE, N_EXPERTS, D, D_FF_EXPERT), D ** -0.5),
        "moe_w3": nrm(ks[23], (N_MOE, N_EXPERTS, D, D_FF_EXPERT), D ** -0.5),
        "moe_w2": nrm(ks[24], (N_MOE, N_EXPERTS, D_FF_EXPERT, D), D_FF_EXPERT ** -0.5),
    }


def reference(x, c, ctx, c_ctx, w_mod, b_mod, g_mix, g_ffn, w_in, dn_conv, dn_a_log, dn_dt_bias, dn_norm_w,
              na_q_norm, na_k_norm, na_rpb, fno_w, w_out, ffn_w1, ffn_w3, ffn_w2,
              moe_router, moe_w1, moe_w3, moe_w2):
    s_lat = jax.nn.silu(c)
    s_ctx = jax.nn.silu(c_ctx)
    for layer in range(DEPTH):
        need_ctx = layer < DEPTH - 1
        mod = jnp.split((s_lat @ w_mod[layer] + b_mod[layer])[:, None, :], N_MOD, axis=-1)
        modc = jnp.split(s_ctx @ w_mod[layer] + b_mod[layer], N_MOD, axis=-1)
        h = rms_norm(x, g_mix[layer]) * (1.0 + mod[1]) + mod[0]
        hc = rms_norm(ctx, g_mix[layer]) * (1.0 + modc[1]) + modc[0]
        y, yc = token_mixers(h, hc, need_ctx, w_in[layer], dn_conv[layer], dn_a_log[layer], dn_dt_bias[layer],
                             dn_norm_w[layer], na_q_norm[layer], na_k_norm[layer], na_rpb[layer],
                             fno_w[layer], w_out[layer])
        x = x + mod[2] * y
        h2 = rms_norm(x, g_ffn[layer]) * (1.0 + mod[4]) + mod[3]
        x = x + mod[5] * channel_mixer(h2, layer, ffn_w1, ffn_w3, ffn_w2, moe_router, moe_w1, moe_w3, moe_w2)
        if need_ctx:
            ctx = ctx + modc[2] * yc
            hc2 = rms_norm(ctx, g_ffn[layer]) * (1.0 + modc[4]) + modc[3]
            ctx = ctx + modc[5] * channel_mixer(hc2, layer, ffn_w1, ffn_w3, ffn_w2,
                                                moe_router, moe_w1, moe_w3, moe_w2)
    return x
```

```cpp
#include <hip/hip_runtime.h>
#include <hip/hip_cooperative_groups.h>
#include <cstdio>
namespace cg = cooperative_groups;
#define LAS __attribute__((address_space(3)))
typedef unsigned short bf16;
typedef short bf16x8 __attribute__((ext_vector_type(8)));
typedef float f32x4 __attribute__((ext_vector_type(4)));
typedef float f32x2 __attribute__((ext_vector_type(2)));
typedef unsigned u32x4 __attribute__((ext_vector_type(4)));
typedef unsigned u32x2 __attribute__((ext_vector_type(2)));

constexpr int DM = 1024, NLAT = 32768, NCTX = 512, NROW = 33280, SEQ = 16384, CTXL = 256;
constexpr int INW = 3088, DFF = 2816, DFFE = 3584, NEXP = 8;
constexpr float EPS = 1e-6f, LOG2E = 1.4426950408889634f;
constexpr int LDS_BYTES = 147456, NWG_WAVES = 8;

constexpr size_t MB = 1048576;
constexpr size_t WS_CTL = 0;
constexpr size_t CTL_MODV = 0;
constexpr size_t CTL_CNT = 160 * 1024;
constexpr size_t WS_TWID = 1 * MB;
constexpr size_t WS_F1 = WS_TWID + 131072;
constexpr size_t WS_A2 = WS_F1 + 65536;
constexpr size_t WS_A2C = WS_A2 + 131072;
constexpr size_t WS_WFT = WS_A2C + 262144;
constexpr size_t WS_GAB = 3 * MB;
constexpr size_t WS_CTXS = 6 * MB;
constexpr size_t WS_TOK = 8 * MB;
constexpr size_t WS_WIN = 10 * MB;
constexpr size_t WS_WOUT = 22 * MB;
constexpr size_t WS_W13 = 26 * MB;
constexpr size_t WS_W2 = 37 * MB;
constexpr size_t WS_HBUF = 43 * MB;
constexpr size_t WS_QKV = 108 * MB;
constexpr size_t WS_Z = 206 * MB;
constexpr size_t WS_NA = 239 * MB;
constexpr size_t WS_FT = 288 * MB;
constexpr size_t WS_VT = 305 * MB;
constexpr size_t WS_Y = 322 * MB;
constexpr size_t WS_DNS = 354 * MB;
constexpr size_t WS_DND = 484 * MB;
constexpr size_t WS_ACT = WS_DNS;
constexpr size_t WS_MW13 = 108 * MB;
constexpr size_t WS_MW2 = 220 * MB;
constexpr size_t WS_XB = 276 * MB;
constexpr size_t WS_MACT = 408 * MB;
constexpr size_t WS_SLOT = 9 * MB;
constexpr int MACT_ROWS = 16384;
constexpr int DNS_ITEM = 65536, DND_ITEM = 17408;

typedef __bf16 bf16x2_t __attribute__((ext_vector_type(2)));
__device__ __forceinline__ unsigned pk2(float lo, float hi) { bf16x2_t v = {(__bf16)lo, (__bf16)hi}; return __builtin_bit_cast(unsigned, v); }
__device__ __forceinline__ float bflo(unsigned u) { return __uint_as_float(u << 16); }
__device__ __forceinline__ float bfhi(unsigned u) { return __uint_as_float(u & 0xffff0000u); }
__device__ __forceinline__ float bf2f(bf16 b) { return __uint_as_float(((unsigned)b) << 16); }
__device__ __forceinline__ bf16 f2bf(float f) { return (bf16)(pk2(f, 0.f) & 0xffffu); }
__device__ __forceinline__ float wave_sum(float v) {
#pragma unroll
    for (int o = 1; o < 64; o <<= 1) v += __shfl_xor(v, o);
    return v;
}
__device__ __forceinline__ float silu_f(float v) { return v / (1.f + __expf(-v)); }
__device__ __forceinline__ bf16x8 mk8(unsigned a, unsigned b, unsigned c, unsigned d) { u32x4 v = {a, b, c, d}; return __builtin_bit_cast(bf16x8, v); }
__device__ __forceinline__ bf16x8 pack8(f32x4 a, f32x4 b) { return mk8(pk2(a[0], a[1]), pk2(a[2], a[3]), pk2(b[0], b[1]), pk2(b[2], b[3])); }
#define MFMA16(a, b, c) __builtin_amdgcn_mfma_f32_16x16x32_bf16((a), (b), (c), 0, 0, 0)
#define LDS_WAIT() asm volatile("s_waitcnt lgkmcnt(0)" ::: "memory")
#define VM_WAIT() asm volatile("s_waitcnt vmcnt(0)" ::: "memory")
__device__ __forceinline__ bf16x8 lds_tr8(unsigned addr, unsigned addr2) {
    u32x2 a, b;
    asm volatile("ds_read_b64_tr_b16 %0, %2\n\tds_read_b64_tr_b16 %1, %3\n\ts_waitcnt lgkmcnt(0)" : "=&v"(a), "=&v"(b) : "v"(addr), "v"(addr2) : "memory");
    return mk8(a.x, a.y, b.x, b.y);
}

struct Args {
    const float* in[25];
    float* out;
    unsigned char* ws;
    int lo, hi;
};
namespace pg8 {
#define PG8_LAS __attribute__((address_space(3)))
typedef unsigned short bf16_t;
typedef short bf16x8 __attribute__((ext_vector_type(8)));
typedef float f32x4 __attribute__((ext_vector_type(4)));
typedef unsigned u32x4 __attribute__((ext_vector_type(4)));
constexpr int BM = 256, BK = 64, HALF = 128, HTB = HALF * BK * 2  , STAGE_BYTES = 8 * HTB, NXCD = 8, WGM = 8;

__host__ __device__ __forceinline__ int lds_byte(int r, int c) { const int st = (r >> 4) * 2 + (c >> 5), rr = r & 15, cc = c & 31, ob = rr * 64 + cc * 2; return st * 1024 + (ob ^ (((ob >> 9) & 1) << 5)); }
__host__ __device__ __forceinline__ void stage_rc(int b, int& R, int& C) { const int st = b / 1024, sb = b % 1024, swz = sb ^ (((sb >> 9) & 1) << 5); R = (st >> 1) * 16 + swz / 64; C = (st & 1) * 32 + (swz % 64) / 2; }
__host__ __device__ __forceinline__ int perm32(int rho) { const int n = rho >> 4, i = rho & 15; return 8 * (i >> 2) + 4 * n + (i & 3); }

struct Unit { int pm, pn; };
struct Gemm { const bf16_t* A; const bf16_t* Bt; int M, N, K; };

struct StaticOrder {
    int nM, nN, nwg, G, c;
    __host__ __device__ void init(int M, int N, int G_, int c_) { nM = M / BM; nN = N / BM; nwg = nM * nN; G = G_; c = c_; }
    __host__ __device__ bool next(int i, Unit& u) const {
        const long L = (long)i * G + c; if (L >= nwg) return false;
        int wgid = (int)L; { const int q = nwg / NXCD, r = nwg % NXCD, xcd = wgid % NXCD, off = wgid / NXCD; wgid = (xcd < r ? xcd * (q + 1) : r * (q + 1) + (xcd - r) * q) + off; }
        const int nig = WGM * nN, gid = wgid / nig, fm = gid * WGM, gsz = (nM - fm) < WGM ? (nM - fm) : WGM;
        u.pm = fm + ((wgid % nig) % gsz); u.pn = (wgid % nig) / gsz; return true;
    }
    __device__ __forceinline__ void a_ready(const Unit&) const {}
    __device__ __forceinline__ void done(const Unit&) const {}
};
__device__ __forceinline__ unsigned cvt_pk_bf16(float lo, float hi) { return pk2(lo, hi); }
template <class Epi, class Sched, bool STAMP = false>
__device__ __forceinline__ void gemm_phase(PG8_LAS unsigned char* lds, const Gemm g, const Sched& S, const Epi& E, unsigned long long* stamps) {
    int tid_l = threadIdx.x; asm volatile("" : "+v"(tid_l)); const int tid = tid_l, wid = __builtin_amdgcn_readfirstlane(tid >> 6), lane = tid & 63, wr = wid >> 2, wc = wid & 3, fr = lane & 15, fq = lane >> 4;
    const int K = g.K, nt = K / BK;
    int ts_lo = 0, ts_hi = 0, nts = 0; const unsigned long long rt_entry = STAMP ? (unsigned long long)wall_clock64() : 0ull;
#define PG8_STAMP() do { if (STAMP && wid == 0 && nts < 64) { const unsigned long long _c = (unsigned long long)clock64(); \
        ts_lo = (lane == nts) ? (int)(unsigned)_c : ts_lo; ts_hi = (lane == nts) ? (int)(unsigned)(_c >> 32) : ts_hi; ++nts; } } while (0)
    PG8_STAMP();
    unsigned voffA[2], voffB[2];
#pragma unroll
    for (int i = 0; i < 2; ++i) { int R, C; stage_rc(tid * 16 + i * 8192, R, C); const int Rb = Epi::PERM ? ((R & ~31) + perm32(R & 31)) : R;
        voffA[i] = (unsigned)(R * K + C) * 2u; voffB[i] = (unsigned)(Rb * K + C) * 2u; }
    const size_t kstep = (size_t)(BK * 2);
    const size_t hstep = (size_t)HALF * K * 2;
    const size_t tstep = 2 * hstep;
    const unsigned ldsw = (unsigned)wid * 1024u;
    const int aoff = lds_byte(wr * 64 + fr, fq * 8), boff = lds_byte(wc * 32 + fr, fq * 8);
#define PG8_SA(b, h) (((b) * 2 + (h)) * HTB)
#define PG8_SB(b, h) ((4 + (b) * 2 + (h)) * HTB)
#define PG8_STAGE(bufoff, gbase, voff) do { _Pragma("unroll") for (int _i = 0; _i < 2; ++_i) \
        __builtin_amdgcn_global_load_lds((const unsigned*)((const char*)(gbase) + (voff)[_i]), (PG8_LAS unsigned*)(lds + (bufoff) + ldsw + _i * 8192), 16, 0, 0); } while (0)
#define PG8_STAGEA(bufoff, gbase, voff) do { _Pragma("unroll") for (int _i = 0; _i < 2; ++_i) \
        __builtin_amdgcn_global_load_lds((const unsigned*)((const char*)(gbase) + (voff)[_i]), (PG8_LAS unsigned*)(lds + (bufoff) + ldsw + _i * 8192), 16, 0, 16); } while (0)
#define PG8_LDA(dst, b, h) do { _Pragma("unroll") for (int m = 0; m < 4; ++m) _Pragma("unroll") for (int k = 0; k < 2; ++k) dst[m][k] = *(const PG8_LAS bf16x8*)(lds + PG8_SA(b, h) + aoff + m * 2048 + k * 1024); } while (0)
#define PG8_LDB(dst, b, h) do { _Pragma("unroll") for (int n = 0; n < 2; ++n) _Pragma("unroll") for (int k = 0; k < 2; ++k) dst[n][k] = *(const PG8_LAS bf16x8*)(lds + PG8_SB(b, h) + boff + n * 2048 + k * 1024); } while (0)
#define PG8_MMA(ai, bj, At, Bt) do { __builtin_amdgcn_s_setprio(1); _Pragma("unroll") for (int m = 0; m < 4; ++m) _Pragma("unroll") for (int n = 0; n < 2; ++n) _Pragma("unroll") for (int k = 0; k < 2; ++k) \
        acc[ai][bj][m][n] = __builtin_amdgcn_mfma_f32_16x16x32_bf16(Bt[n][k], At[m][k], acc[ai][bj][m][n], 0, 0, 0); __builtin_amdgcn_s_setprio(0); } while (0)
#define PG8_WAIT_V(n) asm volatile("s_waitcnt vmcnt(" #n ")" ::: "memory")
#define PG8_WAIT_L(n) asm volatile("s_waitcnt lgkmcnt(" #n ")" ::: "memory")
#define PG8_BAR __builtin_amdgcn_s_barrier()
#define PG8_SCHED __builtin_amdgcn_sched_barrier(0)
    Unit cur, nxt; int ui = 0;
    if (!S.next(0, cur)) return;
    f32x4 acc[2][2][4][2];
#pragma unroll
    for (int a = 0; a < 2; ++a)
#pragma unroll
        for (int b = 0; b < 2; ++b)
#pragma unroll
            for (int m = 0; m < 4; ++m)
#pragma unroll
                for (int n = 0; n < 2; ++n) acc[a][b][m][n] = (f32x4){0.f, 0.f, 0.f, 0.f};
    bf16x8 At[4][2], B0[2][2], B1[2][2];
    const char* cA = (const char*)g.A + (size_t)cur.pm * tstep; const char* cB = (const char*)g.Bt + (size_t)cur.pn * tstep;
    S.a_ready(cur);
    PG8_STAGE(PG8_SB(0, 0), cB, voffB); PG8_STAGEA(PG8_SA(0, 0), cA, voffA); PG8_STAGE(PG8_SB(0, 1), cB + hstep, voffB); PG8_STAGEA(PG8_SA(0, 1), cA + hstep, voffA);
    if (wr == 1) PG8_BAR;
    PG8_WAIT_V(4); PG8_BAR;
    PG8_STAGE(PG8_SB(1, 0), cB + kstep, voffB); PG8_STAGEA(PG8_SA(1, 0), cA + kstep, voffA); PG8_STAGE(PG8_SB(1, 1), cB + hstep + kstep, voffB);
    PG8_WAIT_V(6); PG8_BAR;
    PG8_STAMP();
    for (;;) {
        const bool has_next = S.next(ui + 1, nxt);
        const char* nA = has_next ? (const char*)g.A + (size_t)nxt.pm * tstep : cA; const char* nB = has_next ? (const char*)g.Bt + (size_t)nxt.pn * tstep : cB;
        for (int t = 0; t < nt; t += 2) {
            const bool last = (t == nt - 2);
            const char* a1 = cA + (size_t)(t + 1) * kstep;
            const char* a2 = last ? nA : cA + (size_t)(t + 2) * kstep; const char* b2 = last ? nB : cB + (size_t)(t + 2) * kstep;
            const char* a3 = a2 + kstep; const char* b3 = b2 + kstep;
            if (last && has_next) S.a_ready(nxt);
            PG8_LDB(B0, 0, 0); PG8_SCHED; PG8_LDA(At, 0, 0); PG8_STAGEA(PG8_SA(1, 1), a1 + hstep, voffA);
            PG8_WAIT_L(8); PG8_BAR; PG8_WAIT_L(0); PG8_MMA(0, 0, At, B0); PG8_BAR; PG8_SCHED;
            PG8_LDB(B1, 0, 1); PG8_STAGE(PG8_SB(0, 0), b2, voffB);
            PG8_BAR; PG8_WAIT_L(0); PG8_MMA(0, 1, At, B1); PG8_BAR;
            PG8_LDA(At, 0, 1); PG8_STAGEA(PG8_SA(0, 0), a2, voffA);
            PG8_BAR; PG8_WAIT_L(0); PG8_MMA(1, 0, At, B0); PG8_BAR; PG8_SCHED;
            PG8_STAGE(PG8_SB(0, 1), b2 + hstep, voffB);
            PG8_WAIT_V(6); PG8_BAR; PG8_MMA(1, 1, At, B1); PG8_BAR;
            PG8_LDB(B0, 1, 0); PG8_SCHED; PG8_LDA(At, 1, 0); PG8_STAGEA(PG8_SA(0, 1), a2 + hstep, voffA);
            PG8_WAIT_L(8); PG8_BAR; PG8_WAIT_L(0); PG8_MMA(0, 0, At, B0); PG8_BAR; PG8_SCHED;
            PG8_LDB(B1, 1, 1); PG8_STAGE(PG8_SB(1, 0), b3, voffB);
            PG8_BAR; PG8_WAIT_L(0); PG8_MMA(0, 1, At, B1); PG8_BAR;
            PG8_LDA(At, 1, 1); PG8_STAGEA(PG8_SA(1, 0), a3, voffA);
            PG8_BAR; PG8_WAIT_L(0); PG8_MMA(1, 0, At, B0); PG8_BAR; PG8_SCHED;
            PG8_STAGE(PG8_SB(1, 1), b3 + hstep, voffB);
            PG8_WAIT_V(6); PG8_BAR; PG8_MMA(1, 1, At, B1); PG8_BAR;
        }
        PG8_STAMP();
        if constexpr (!Epi::AFTER_DRAIN) { E(acc, cur, wr, wc, fr, fq); S.done(cur); }
        PG8_STAMP();
        if (!has_next) break;
#pragma unroll
        for (int a = 0; a < 2; ++a)
#pragma unroll
            for (int b = 0; b < 2; ++b)
#pragma unroll
                for (int m = 0; m < 4; ++m)
#pragma unroll
                    for (int n = 0; n < 2; ++n) acc[a][b][m][n] = (f32x4){0.f, 0.f, 0.f, 0.f};
        cur = nxt; cA = nA; cB = nB; ++ui;
    }
    PG8_WAIT_V(0);
    if (wr == 0) PG8_BAR;
    PG8_BAR;
    if constexpr (Epi::AFTER_DRAIN) { E.fused(acc, cur, wr, wc, fr, fq, lds, wid, lane); S.done(cur); }
    PG8_STAMP();
    if (STAMP && wid == 0) { stamps[lane] = lane < nts ? (((unsigned long long)(unsigned)ts_hi << 32) | (unsigned)ts_lo) : 0ull;
        if (lane == 62) stamps[62] = rt_entry; if (lane == 63) stamps[63] = (unsigned long long)wall_clock64(); }
#undef PG8_STAMP
#undef PG8_SA
#undef PG8_SB
#undef PG8_STAGE
#undef PG8_STAGEA
#undef PG8_LDA
#undef PG8_LDB
#undef PG8_MMA
#undef PG8_WAIT_V
#undef PG8_WAIT_L
#undef PG8_BAR
#undef PG8_SCHED
}
}
__device__ __forceinline__ void tr_item(const float* W, int ldn, int k0, int nsrc0, bf16* dst, int ldk, LAS float* scr, int lane) {
#pragma unroll 8
    for (int i = 0; i < 32; ++i) { const int kk = 2 * i + (lane >> 5); scr[kk * 33 + (lane & 31)] = W[(size_t)(k0 + kk) * ldn + nsrc0 + (lane & 31)]; }
    LDS_WAIT();
    const int c = lane & 7;
#pragma unroll
    for (int j = 0; j < 4; ++j) { const int n = (lane >> 3) + 8 * j; const LAS float* s = scr + (8 * c) * 33 + n;
        u32x4 o; o.x = pk2(s[0 * 33], s[1 * 33]); o.y = pk2(s[2 * 33], s[3 * 33]); o.z = pk2(s[4 * 33], s[5 * 33]); o.w = pk2(s[6 * 33], s[7 * 33]);
        *(u32x4*)(dst + (size_t)n * ldk + k0 + 8 * c) = o; }
    LDS_WAIT();
}
__device__ __forceinline__ int w13_row(int f) { return 256 * (f >> 7) + (f & 127); }

__device__ __forceinline__ void phase_prologue(const Args& a, LAS unsigned char* lds, int gw, int ngw, int wave, int lane, int gtid, int ngt) {
    unsigned char* ws = a.ws;
    LAS float* scr = (LAS float*)(lds + wave * 16384);
    constexpr int N_GEMV = 192, I_WIN = 1536, I_WOUT = 512, I_W1 = 1408, I_W2 = 1408;
    constexpr int N_ITEMS = N_GEMV + 2 * I_WIN + 2 * I_WOUT + 2 * I_W1 + I_W2;
    for (int it = gw; it < N_ITEMS; it += ngw) {
        int r = it;
        if (r < N_GEMV) {
            const int l = r / 96, cb = r % 96, col = 64 * cb + lane;
            const float* wm = a.in[4] + (size_t)l * 1024 * 6144 + col;
            const float* c0 = a.in[1]; const float* cc = a.in[3];
            float a0[4] = {0.f, 0.f, 0.f, 0.f}, a1[4] = {0.f, 0.f, 0.f, 0.f}, a2[4] = {0.f, 0.f, 0.f, 0.f};
#pragma unroll 2
            for (int k = 0; k < 1024; k += 4) {
#pragma unroll
                for (int u = 0; u < 4; ++u) { const float w = wm[(size_t)(k + u) * 6144];
                    a0[u] += silu_f(c0[k + u]) * w; a1[u] += silu_f(c0[1024 + k + u]) * w; a2[u] += silu_f(cc[k + u]) * w; }
            }
            const float b = a.in[5][l * 6144 + col];
            float* mv = (float*)(ws + WS_CTL + CTL_MODV) + (size_t)l * 3 * 6144 + col;
            mv[0] = ((a0[0] + a0[1]) + (a0[2] + a0[3])) + b; mv[6144] = ((a1[0] + a1[1]) + (a1[2] + a1[3])) + b; mv[2 * 6144] = ((a2[0] + a2[1]) + (a2[2] + a2[3])) + b;
            continue;
        }
        r -= N_GEMV;
        if (r < 2 * I_WIN) { const int l = r / I_WIN, q = r % I_WIN, kb = q / 96, nb = q % 96, n0 = 32 * nb;
            tr_item(a.in[8] + (size_t)l * 1024 * INW, INW, 64 * kb, n0 + (n0 >= 2048 ? 16 : 0), (bf16*)(ws + WS_WIN) + ((size_t)l * 3072 + n0) * 1024, 1024, scr, lane); continue; }
        r -= 2 * I_WIN;
        if (r < 2 * I_WOUT) { const int l = r / I_WOUT, q = r % I_WOUT, kb = q / 32, nb = q % 32;
            tr_item(a.in[17] + (size_t)l * 1024 * 1024, 1024, 64 * kb, 32 * nb, (bf16*)(ws + WS_WOUT) + ((size_t)l * 1024 + 32 * nb) * 1024, 1024, scr, lane); continue; }
        r -= 2 * I_WOUT;
        if (r < 2 * I_W1) { const int which = r / I_W1, q = r % I_W1, kb = q / 88, nb = q % 88;
            tr_item(a.in[which ? 19 : 18], DFF, 64 * kb, 32 * nb, (bf16*)(ws + WS_W13) + (size_t)(w13_row(32 * nb) + 128 * which) * 1024, 1024, scr, lane); continue; }
        r -= 2 * I_W1;
        { const int kb = r / 32, nb = r % 32;
            tr_item(a.in[20], 1024, 64 * kb, 32 * nb, (bf16*)(ws + WS_W2) + (size_t)(32 * nb) * DFF, DFF, scr, lane); }
    }
    for (int i = gtid; i < 16384; i += ngt) { float s, c; sincospif((float)i * (1.0f / 8192.0f), &s, &c); ((f32x2*)(ws + WS_TWID))[i] = (f32x2){c, s}; }
    for (int i = gtid; i < 32768; i += ngt) { const int row = i >> 7, t1 = i & 127, c = row >> 7, kb = row & 127; const float ang = (float)((kb * t1) & 127) * (1.0f / 64.0f);
        ((bf16*)(ws + WS_F1))[i] = f2bf(c == 0 ? cospif(ang) : -sinpif(ang)); }
    for (int i = gtid; i < 65536; i += ngt) { const int row = i >> 8, col = i & 255, c = row >> 7, ka = row & 127, c2 = col >> 7, t0 = col & 127; const float ang = (float)((ka * t0) & 127) * (1.0f / 64.0f);
        const float cs = cospif(ang), sn = sinpif(ang); ((bf16*)(ws + WS_A2))[i] = f2bf(c == c2 ? cs : (c == 0 ? sn : -sn)); }
    for (int i = gtid; i < 131072; i += ngt) { const int kh = i >> 16, row = (i >> 8) & 255, t = i & 255, c = row >> 7, ka = row & 127, k = 128 * kh + ka; const float ang = (float)((k * t) & 255) * (1.0f / 128.0f);
        ((bf16*)(ws + WS_A2C))[i] = f2bf(c == 0 ? cospif(ang) : -sinpif(ang)); }
    for (int i = gtid; i < 262144; i += ngt) { const int l = i >> 17, mt = (i >> 13) & 15, kk = (i >> 9) & 15, ln = (i >> 3) & 63, e = i & 7;
        const int j = 16 * mt + (ln & 15), g = ln >> 4, kidx = 32 * kk + (e < 4 ? 4 * g + e : 16 + 4 * g + e - 4), c = kidx >> 8, ch = kidx & 255, grp = ch >> 6, n = ch & 63;
        const float* fw = a.in[16] + (size_t)l * 65536 + (size_t)(grp * 64) * 256 + j; float s = 0.f;
        for (int m = 0; m < 64; ++m) { const float ang = (float)((m * n) & 63) * (1.0f / 32.0f); s += (c == 0 ? cospif(ang) : sinpif(ang)) * fw[m * 256]; }
        ((bf16*)(ws + WS_WFT))[i] = f2bf(s * (1.0f / 1024.0f)); }
}

__device__ __forceinline__ void phase_A(const Args& a, int l, LAS unsigned char* lds, int gw, int ngw, int tid, int lane) {
    unsigned char* ws = a.ws;
    LAS float* wab = (LAS float*)lds;
    const float* win = a.in[8] + (size_t)l * 1024 * INW + 2048;
    for (int i = tid; i < 16384; i += 512) { const int k = i >> 4, o = i & 15; wab[o * 1024 + k] = win[(size_t)k * INW + o]; }
    __syncthreads();
    const float* gm = a.in[6] + l * 1024;
    const float* modv = (const float*)(ws + WS_CTL + CTL_MODV) + (size_t)l * 3 * 6144;
    const float* xl = l == 0 ? a.in[0] : a.out; const float* xc = l == 0 ? a.in[2] : (const float*)(ws + WS_CTXS);
    bf16* hb = (bf16*)(ws + WS_HBUF); float* gab = (float*)(ws + WS_GAB);
    for (int row = gw; row < NROW; row += ngw) {
        const float* xr = row < NLAT ? xl + (size_t)row * 1024 : xc + (size_t)(row - NLAT) * 1024;
        const int bi = row < NLAT ? (row >> 14) : 2; const float* md = modv + bi * 6144;
        f32x4 v[4]; float ss = 0.f;
#pragma unroll
        for (int j = 0; j < 4; ++j) { v[j] = *(const f32x4*)(xr + 4 * lane + 256 * j); ss += (v[j][0] * v[j][0] + v[j][1] * v[j][1]) + (v[j][2] * v[j][2] + v[j][3] * v[j][3]); }
        const float rinv = rsqrtf(wave_sum(ss) * (1.0f / 1024.0f) + EPS);
        float p[16];
#pragma unroll
        for (int o = 0; o < 16; ++o) p[o] = 0.f;
#pragma unroll
        for (int j = 0; j < 4; ++j) { const int k = 4 * lane + 256 * j; const f32x4 g4 = *(const f32x4*)(gm + k), sc = *(const f32x4*)(md + 1024 + k), sh = *(const f32x4*)(md + k);
            f32x4 h = v[j] * rinv * g4 * (sc + 1.0f) + sh; v[j] = h;
            *(u32x2*)(hb + (size_t)row * 1024 + k) = (u32x2){pk2(h[0], h[1]), pk2(h[2], h[3])};
#pragma unroll
            for (int o = 0; o < 16; ++o) { const f32x4 w4 = *(const LAS f32x4*)(wab + o * 1024 + k); p[o] += (h[0] * w4[0] + h[1] * w4[1]) + (h[2] * w4[2] + h[3] * w4[3]); } }
        float mine = 0.f;
#pragma unroll
        for (int o = 0; o < 16; ++o) { const float s = wave_sum(p[o]); if (lane == o) mine = s; }
        if (lane < 8) { const float al = mine + a.in[11][l * 8 + lane]; const float sp = fmaxf(al, 0.f) + log1pf(__expf(-fabsf(al)));
            gab[(size_t)row * 16 + lane] = -__expf(a.in[10][l * 8 + lane]) * sp; }
        else if (lane < 16) gab[(size_t)row * 16 + lane] = 1.0f / (1.0f + __expf(-mine));
    }
    __syncthreads();
}
__device__ __forceinline__ void phase_F(const Args& a, int l, LAS unsigned char* lds, int gw, int ngw, int tid, int lane) {
    unsigned char* ws = a.ws;
    LAS float* wrt = (LAS float*)lds;
    if (l == 1) { for (int i = tid; i < 8192; i += 512) { const int k = i >> 3, e = i & 7; wrt[e * 1024 + k] = a.in[21][i]; } __syncthreads(); }
    const float* gm = a.in[7] + l * 1024;
    const float* modv = (const float*)(ws + WS_CTL + CTL_MODV) + (size_t)l * 3 * 6144;
    const float* xl = a.out; const float* xc = (const float*)(ws + WS_CTXS);
    bf16* hb = (bf16*)(ws + WS_HBUF);
    int* tok_e = (int*)(ws + WS_TOK); float* tok_w = (float*)(ws + WS_TOK + 262144);
    const int nrow = l == 0 ? NROW : NLAT; int mycnt = 0;
    const int per = (nrow + ngw - 1) / ngw;
    for (int row = gw * per; row < gw * per + per && row < nrow; ++row) {
        const float* xr = row < NLAT ? xl + (size_t)row * 1024 : xc + (size_t)(row - NLAT) * 1024;
        const int bi = row < NLAT ? (row >> 14) : 2; const float* md = modv + bi * 6144;
        f32x4 v[4]; float ss = 0.f;
#pragma unroll
        for (int j = 0; j < 4; ++j) { v[j] = *(const f32x4*)(xr + 4 * lane + 256 * j); ss += (v[j][0] * v[j][0] + v[j][1] * v[j][1]) + (v[j][2] * v[j][2] + v[j][3] * v[j][3]); }
        const float rinv = rsqrtf(wave_sum(ss) * (1.0f / 1024.0f) + EPS);
        float p[8];
#pragma unroll
        for (int o = 0; o < 8; ++o) p[o] = 0.f;
#pragma unroll
        for (int j = 0; j < 4; ++j) { const int k = 4 * lane + 256 * j; const f32x4 g4 = *(const f32x4*)(gm + k), sc = *(const f32x4*)(md + 4096 + k), sh = *(const f32x4*)(md + 3072 + k);
            const f32x4 h = v[j] * rinv * g4 * (sc + 1.0f) + sh;
            *(u32x2*)(hb + (size_t)row * 1024 + k) = (u32x2){pk2(h[0], h[1]), pk2(h[2], h[3])};
            if (l == 1) {
#pragma unroll
                for (int o = 0; o < 8; ++o) { const f32x4 w4 = *(const LAS f32x4*)(wrt + o * 1024 + k); p[o] += (h[0] * w4[0] + h[1] * w4[1]) + (h[2] * w4[2] + h[3] * w4[3]); } } }
        if (l == 1) {
            float lg[8];
#pragma unroll
            for (int o = 0; o < 8; ++o) lg[o] = wave_sum(p[o]);
            int e0 = 0; float l0 = lg[0];
#pragma unroll
            for (int o = 1; o < 8; ++o) if (lg[o] > l0) { l0 = lg[o]; e0 = o; }
            int e1 = -1; float l1 = -3.0e38f;
#pragma unroll
            for (int o = 0; o < 8; ++o) if (o != e0 && lg[o] > l1) { l1 = lg[o]; e1 = o; }
            const float w1 = 1.0f / (1.0f + __expf(l0 - l1)), w0 = 1.0f - w1;
            if (lane == 0) { tok_e[2 * row] = e0; tok_e[2 * row + 1] = e1; tok_w[2 * row] = w0; tok_w[2 * row + 1] = w1; }
            mycnt += (lane == e0) + (lane == e1);
        }
    }
    if (l == 1 && lane < 8 && mycnt > 0) atomicAdd((int*)(ws + WS_CTL + CTL_CNT) + lane, mycnt);
    if (l == 1 && lane < 8) ((int*)(ws + WS_CTL + 262144))[gw * 8 + lane] = mycnt;
    __syncthreads();
}
namespace pg8 {
struct EpiProj {
    static constexpr bool PERM = true, AFTER_DRAIN = false; unsigned char* ws;
    __device__ __forceinline__ void operator()(const f32x4 (&acc)[2][2][4][2], const Unit& u, int wr, int wc, int fr, int fq) const {
        const int row0 = u.pm * BM + wr * 64 + fr, pn = u.pn; bf16_t* base; int ldc, colt;
        if (pn < 6) { base = (bf16_t*)(ws + WS_QKV); ldc = 1536; colt = pn * 256; } else if (pn < 8) { base = (bf16_t*)(ws + WS_Z); ldc = 512; colt = (pn - 6) * 256; }
        else if (pn < 11) { base = (bf16_t*)(ws + WS_NA); ldc = 768; colt = (pn - 8) * 256; } else { base = (bf16_t*)(ws + WS_FT); ldc = 256; colt = 0; }
        const int col0 = colt + wc * 32 + 8 * fq;
#pragma unroll
        for (int ai = 0; ai < 2; ++ai)
#pragma unroll
            for (int m = 0; m < 4; ++m) { bf16_t* rowp = base + (size_t)(row0 + ai * HALF + m * 16) * ldc + col0;
#pragma unroll
                for (int bj = 0; bj < 2; ++bj) { const f32x4 v0 = acc[ai][bj][m][0], v1 = acc[ai][bj][m][1];
                    u32x4 w; w.x = cvt_pk_bf16(v0[0], v0[1]); w.y = cvt_pk_bf16(v0[2], v0[3]); w.z = cvt_pk_bf16(v1[0], v1[1]); w.w = cvt_pk_bf16(v1[2], v1[3]);
                    *(u32x4*)(rowp + bj * HALF) = w; } }
    }
};
struct EpiResid {
    static constexpr bool PERM = false, AFTER_DRAIN = false;
    const float* src_lat; const float* src_ctx; float* dst_lat; float* dst_ctx; const float* gate;
    __device__ __forceinline__ void operator()(const f32x4 (&acc)[2][2][4][2], const Unit& u, int wr, int wc, int fr, int fq) const {
        const int row0 = u.pm * BM + wr * 64 + fr, col0 = u.pn * BM + wc * 32 + 4 * fq;
#pragma unroll
        for (int ai = 0; ai < 2; ++ai)
#pragma unroll
            for (int m = 0; m < 4; ++m) { const int row = row0 + ai * HALF + m * 16; const bool lat = row < NLAT; const size_t ro = lat ? (size_t)row * 1024 : (size_t)(row - NLAT) * 1024;
                const float* s = (lat ? src_lat : src_ctx) + ro + col0; float* d = (lat ? dst_lat : dst_ctx) + ro + col0; const float* g = gate + (lat ? (row >> 14) : 2) * 6144 + col0;
#pragma unroll
                for (int bj = 0; bj < 2; ++bj)
#pragma unroll
                    for (int n = 0; n < 2; ++n) { const int o = bj * HALF + n * 16; *(f32x4*)(d + o) = *(const f32x4*)(s + o) + *(const f32x4*)(g + o) * acc[ai][bj][m][n]; } }
    }
};
struct EpiSwiglu {
    static constexpr bool PERM = true, AFTER_DRAIN = false; bf16_t* act; int ldc; int row_off;
    __device__ __forceinline__ void operator()(const f32x4 (&acc)[2][2][4][2], const Unit& u, int wr, int wc, int fr, int fq) const {
        const int row0 = u.pm * BM - row_off + wr * 64 + fr, col0 = u.pn * HALF + wc * 32 + 8 * fq;
#pragma unroll
        for (int ai = 0; ai < 2; ++ai)
#pragma unroll
            for (int m = 0; m < 4; ++m) { bf16_t* rowp = act + (size_t)(row0 + ai * HALF + m * 16) * ldc + col0;
                float o[8];
#pragma unroll
                for (int n = 0; n < 2; ++n)
#pragma unroll
                    for (int i = 0; i < 4; ++i) { const float x = acc[ai][0][m][n][i], y = acc[ai][1][m][n][i]; o[4 * n + i] = x / (1.0f + __expf(-x)) * y; }
                u32x4 w; w.x = cvt_pk_bf16(o[0], o[1]); w.y = cvt_pk_bf16(o[2], o[3]); w.z = cvt_pk_bf16(o[4], o[5]); w.w = cvt_pk_bf16(o[6], o[7]);
                *(u32x4*)rowp = w; }
    }
};
struct EpiBf16Out {
    static constexpr bool PERM = true, AFTER_DRAIN = false; bf16_t* O; int ldc;
    __device__ __forceinline__ void operator()(const f32x4 (&acc)[2][2][4][2], const Unit& u, int wr, int wc, int fr, int fq) const {
        const int row0 = u.pm * BM + wr * 64 + fr, col0 = u.pn * BM + wc * 32 + 8 * fq;
#pragma unroll
        for (int ai = 0; ai < 2; ++ai)
#pragma unroll
            for (int m = 0; m < 4; ++m) { bf16_t* rowp = O + (size_t)(row0 + ai * HALF + m * 16) * ldc + col0;
#pragma unroll
                for (int bj = 0; bj < 2; ++bj) { const f32x4 v0 = acc[ai][bj][m][0], v1 = acc[ai][bj][m][1];
                    u32x4 w; w.x = cvt_pk_bf16(v0[0], v0[1]); w.y = cvt_pk_bf16(v0[2], v0[3]); w.z = cvt_pk_bf16(v1[0], v1[1]); w.w = cvt_pk_bf16(v1[2], v1[3]);
                    *(u32x4*)(rowp + bj * HALF) = w; } }
    }
};
struct MoeOrder {
    int nM, nN, mb0, G, c;
    __device__ __forceinline__ bool next(int i, Unit& u) const { const long L = (long)i * G + c; if (L >= (long)nM * nN) return false; u.pm = mb0 + (int)(L % nM); u.pn = (int)(L / nM); return true; }
    __device__ __forceinline__ void a_ready(const Unit&) const {}
    __device__ __forceinline__ void done(const Unit&) const {}
};
}

__device__ __forceinline__ void moe_pads(const unsigned char* ws, int (&ps)[9]) {
    const int* cnt = (const int*)(ws + WS_CTL + CTL_CNT); int acc = 0;
#pragma unroll
    for (int e = 0; e < 8; ++e) { ps[e] = acc; const int c = __builtin_amdgcn_readfirstlane(__hip_atomic_load(cnt + e, __ATOMIC_RELAXED, __HIP_MEMORY_SCOPE_AGENT)); acc += (c + 255) / 256 * 256; }
    ps[8] = acc;
}
__device__ __forceinline__ void phase_moe_assign(const Args& a, int gw, int lane) {
    unsigned char* ws = a.ws;
    int ps[9]; moe_pads(ws, ps);
    const int* tok_e = (const int*)(ws + WS_TOK); const float* tok_w = (const float*)(ws + WS_TOK + 262144); int* tok_slot = (int*)(ws + WS_TOK + 524288);
    int* slot_tok = (int*)(ws + WS_SLOT); float* slot_w = (float*)(ws + WS_SLOT + 270336);
    const bf16* hb = (const bf16*)(ws + WS_HBUF); bf16* xb = (bf16*)(ws + WS_XB);
    const int row = gw * 16 + (lane & 15), k = (lane >> 4) & 1; const bool act = lane < 32;
    const int e = act ? tok_e[2 * row + k] : -1; int slot = 0;
#pragma unroll
    for (int ee = 0; ee < 8; ++ee) {
        const unsigned long long mask = __ballot(e == ee);
        { int sb = 0; const int* wc = (const int*)(ws + WS_CTL + 262144);
            for (int w = lane; w < gw; w += 64) sb += wc[w * 8 + ee];
#pragma unroll
            for (int o = 1; o < 64; o <<= 1) sb += __shfl_xor(sb, o);
            if (e == ee) slot = ps[ee] + sb + __popcll(mask & ((1ull << lane) - 1ull)); }
    }
    if (act) { slot_tok[slot] = row; slot_w[slot] = tok_w[2 * row + k]; tok_slot[2 * row + k] = slot; }
    for (int i = 0; i < 32; ++i) { const int r = __shfl(row, i), s = __shfl(slot, i);
        const u32x4* src = (const u32x4*)(hb + (size_t)r * 1024); u32x4* dst = (u32x4*)(xb + (size_t)s * 1024);
        dst[lane] = src[lane]; dst[lane + 64] = src[lane + 64]; }
}
__device__ __forceinline__ void phase_moe_convert(const Args& a, LAS unsigned char* lds, int gw, int ngw, int wave, int lane) {
    unsigned char* ws = a.ws; LAS float* scr = (LAS float*)(lds + wave * 16384);
    constexpr int I_W1 = 16 * 112, I_W2 = 56 * 32, PER_E = 2 * I_W1 + I_W2;
    for (int it = gw; it < 8 * PER_E; it += ngw) {
        const int e = it / PER_E; int r = it % PER_E;
        if (r < 2 * I_W1) { const int which = r / I_W1, q = r % I_W1, kb = q / 112, nb = q % 112;
            tr_item(a.in[which ? 23 : 22] + (size_t)e * 1024 * DFFE, DFFE, 64 * kb, 32 * nb, (bf16*)(ws + WS_MW13) + ((size_t)e * 7168 + w13_row(32 * nb) + 128 * which) * 1024, 1024, scr, lane); continue; }
        r -= 2 * I_W1;
        { const int kb = r / 32, nb = r % 32;
            tr_item(a.in[24] + (size_t)e * DFFE * 1024, 1024, 64 * kb, 32 * nb, (bf16*)(ws + WS_MW2) + ((size_t)e * 1024 + 32 * nb) * DFFE, DFFE, scr, lane); }
    }
}
__device__ __forceinline__ void phase_moe_combine(const Args& a, int gw, int ngw, int lane) {
    unsigned char* ws = a.ws;
    const float* tok_w = (const float*)(ws + WS_TOK + 262144); const int* tok_slot = (const int*)(ws + WS_TOK + 524288);
    const bf16* y = (const bf16*)(ws + WS_XB);
    const float* gate = (const float*)(ws + WS_CTL + CTL_MODV) + (size_t)3 * 6144 + 5120;
    for (int row = gw; row < NLAT; row += ngw) {
        const int s0 = tok_slot[2 * row], s1 = tok_slot[2 * row + 1]; const float w0 = tok_w[2 * row], w1 = tok_w[2 * row + 1];
        float* xr = a.out + (size_t)row * 1024; const float* g = gate + (row >> 14) * 6144;
#pragma unroll
        for (int j = 0; j < 4; ++j) { const int k = 4 * lane + 256 * j;
            const u32x2 ya = *(const u32x2*)(y + (size_t)s0 * 1024 + k), yb = *(const u32x2*)(y + (size_t)s1 * 1024 + k);
            f32x4 m; m[0] = w0 * bflo(ya.x) + w1 * bflo(yb.x); m[1] = w0 * bfhi(ya.x) + w1 * bfhi(yb.x); m[2] = w0 * bflo(ya.y) + w1 * bflo(yb.y); m[3] = w0 * bfhi(ya.y) + w1 * bfhi(yb.y);
            *(f32x4*)(xr + k) = *(const f32x4*)(xr + k) + *(const f32x4*)(g + k) * m; }
    }
}
constexpr int PQ = 0, PK = 17408, PV = 34816, PKK = 52224, PAS = 85504, PTS = 118272, PGC = 136704;
__device__ __forceinline__ void dn_prep_item(const Args& a, int l, int item, LAS unsigned char* lds, int tid, int wave, int lane) {
    unsigned char* ws = a.ws;
    const int h = item & 3, cs = (item >> 2) % 260, b = (item >> 2) / 260;
    const int rowbase = cs < 4 ? NLAT + b * CTXL + 64 * cs : b * SEQ + 64 * (cs - 4);
    const int seqlo = cs < 4 ? NLAT + b * CTXL : b * SEQ, seqhi = cs < 4 ? seqlo + CTXL : seqlo + SEQ;
    const bf16* qkv = (const bf16*)(ws + WS_QKV);
    unsigned char* dns = ws + WS_DNS + (size_t)item * DNS_ITEM;
    {
        const int r = tid >> 3, cgp = tid & 7, row = rowbase + r;
        float vals[3][16];
#pragma unroll
        for (int sec = 0; sec < 3; ++sec) {
            const int ch = sec * 512 + h * 128 + cgp * 16;
            const float* cw = a.in[9] + (size_t)l * 3 * 1536 + ch;
            float acc[16];
#pragma unroll
            for (int e = 0; e < 16; ++e) acc[e] = 0.f;
#pragma unroll
            for (int j = 0; j < 3; ++j) { const int rr = row + j - 1;
                if (rr >= seqlo && rr < seqhi) { const u32x4 p0 = *(const u32x4*)(qkv + (size_t)rr * 1536 + ch), p1 = *(const u32x4*)(qkv + (size_t)rr * 1536 + ch + 8);
                    const unsigned pw[8] = {p0.x, p0.y, p0.z, p0.w, p1.x, p1.y, p1.z, p1.w};
#pragma unroll
                    for (int e = 0; e < 8; ++e) { acc[2 * e] += bflo(pw[e]) * cw[j * 1536 + 2 * e]; acc[2 * e + 1] += bfhi(pw[e]) * cw[j * 1536 + 2 * e + 1]; } } }
#pragma unroll
            for (int e = 0; e < 16; ++e) vals[sec][e] = silu_f(acc[e]);
        }
#pragma unroll
        for (int sec = 0; sec < 3; ++sec) {
            float sc = 1.0f;
            if (sec < 2) { float ss = 0.f;
#pragma unroll
                for (int e = 0; e < 16; ++e) ss += vals[sec][e] * vals[sec][e];
                ss += __shfl_xor(ss, 1); ss += __shfl_xor(ss, 2); ss += __shfl_xor(ss, 4);
                sc = rsqrtf(ss + EPS); }
            LAS unsigned* dst = (LAS unsigned*)(lds + (sec == 0 ? PQ : sec == 1 ? PK : PV) + r * 272 + cgp * 32);
#pragma unroll
            for (int e = 0; e < 8; ++e) dst[e] = pk2(vals[sec][2 * e] * sc, vals[sec][2 * e + 1] * sc);
        }
    }
    __syncthreads();
    {
#pragma unroll
        for (int i = 0; i < 2; ++i) { const int p = tid + 512 * i, mt = p >> 8, kk = (p >> 6) & 3, ln = p & 63, row = 16 * mt + (ln & 15), g = ln >> 4;
#pragma unroll
            for (int which = 0; which < 2; ++which) { const LAS unsigned char* src = lds + (which ? PK : PQ) + row * 272 + (32 * kk + 4 * g) * 2;
                const u32x2 lo = *(const LAS u32x2*)src, hi = *(const LAS u32x2*)(src + 32);
                *(u32x4*)(dns + which * 16384 + (size_t)p * 16) = (u32x4){lo.x, lo.y, hi.x, hi.y}; } }
#pragma unroll
        for (int i = 0; i < 2; ++i) { const int p = tid + 512 * i, mt = p >> 7, kk = (p >> 6) & 1, ln = p & 63, dk = 16 * mt + (ln & 15), g = ln >> 4;
            const LAS bf16* ks = (const LAS bf16*)(lds + PK); unsigned w[4];
#pragma unroll
            for (int e = 0; e < 4; ++e) { const int t0 = 32 * kk + (e < 2 ? 4 * g + 2 * e : 16 + 4 * g + 2 * (e - 2)); w[e] = (unsigned)ks[t0 * 136 + dk] | ((unsigned)ks[(t0 + 1) * 136 + dk] << 16); }
            *(u32x4*)(dns + 32768 + (size_t)p * 16) = (u32x4){w[0], w[1], w[2], w[3]}; }
#pragma unroll
        for (int i = 0; i < 4; ++i) { const int p = tid + 512 * i, s = p >> 8, mt = (p >> 6) & 3, ln = p & 63, tok = 16 * mt + 4 * (ln >> 4), dv = 16 * s + (ln & 15);
            const LAS bf16* vs = (const LAS bf16*)(lds + PV);
            *(u32x2*)(dns + 49152 + (size_t)p * 8) = (u32x2){(unsigned)vs[tok * 136 + dv] | ((unsigned)vs[(tok + 1) * 136 + dv] << 16), (unsigned)vs[(tok + 2) * 136 + dv] | ((unsigned)vs[(tok + 3) * 136 + dv] << 16)}; }
    }
    {
#pragma unroll
        for (int t = 0; t < 4; ++t) { const int T = 4 * wave + t, which = T >> 4, ti = (T >> 2) & 3, tj = T & 3; f32x4 acc = {0.f, 0.f, 0.f, 0.f};
#pragma unroll
            for (int kk = 0; kk < 4; ++kk) { const bf16x8 av = *(const LAS bf16x8*)(lds + (which ? PQ : PK) + (16 * ti + (lane & 15)) * 272 + (32 * kk + 8 * (lane >> 4)) * 2);
                const bf16x8 bv = *(const LAS bf16x8*)(lds + PK + (16 * tj + (lane & 15)) * 272 + (32 * kk + 8 * (lane >> 4)) * 2);
                acc = MFMA16(av, bv, acc); }
            LAS float* o = (LAS float*)(lds + PKK) + which * 4160 + (16 * ti + 4 * (lane >> 4)) * 65 + 16 * tj + (lane & 15);
#pragma unroll
            for (int r = 0; r < 4; ++r) o[r * 65] = acc[r]; }
    }
    if (wave < 2) { const int d = wave, tok = d ? 63 - lane : lane; const float* gb = (const float*)(ws + WS_GAB) + (size_t)(rowbase + tok) * 16;
        float gc = gb[d * 4 + h]; const float bt = gb[8 + d * 4 + h];
#pragma unroll
        for (int o = 1; o < 64; o <<= 1) { const float t = __shfl_up(gc, o); if (lane >= o) gc += t; }
        const float glast = __shfl(gc, 63);
        LAS float* gcs = (LAS float*)(lds + PGC) + d * 128; gcs[tok] = gc; gcs[64 + tok] = bt;
        float* aux = (float*)(ws + WS_DND + (size_t)(item * 2 + d) * DND_ITEM + 16384);
        aux[tok] = bt; aux[64 + tok] = __expf(gc); aux[128 + tok] = __expf(glast - gc); if (lane == 0) aux[192] = __expf(glast); }
    __syncthreads();
    {
        const LAS float* kkm = (const LAS float*)(lds + PKK); const LAS float* qkm = kkm + 4160;
#pragma unroll
        for (int d = 0; d < 2; ++d) { const LAS float* gcs = (const LAS float*)(lds + PGC) + d * 128; LAS float* as = (LAS float*)(lds + PAS) + d * 4096;
            for (int idx = tid; idx < 4096; idx += 512) { const int p = idx >> 6, p2 = idx & 63, i = d ? 63 - p : p, j = d ? 63 - p2 : p2;
                as[idx] = p2 < p ? gcs[64 + i] * kkm[i * 65 + j] * __expf(gcs[i] - gcs[j]) : 0.f; }
            { const int mt = tid >> 7, kk = (tid >> 6) & 1, ln = tid & 63, i = 16 * mt + (ln & 15), g = ln >> 4; float v[8];
#pragma unroll
                for (int e = 0; e < 8; ++e) { const int j = 32 * kk + (e < 4 ? 4 * g + e : 16 + 4 * g + e - 4); const bool ok = d ? (j >= i) : (j <= i);
                    v[e] = ok ? qkm[i * 65 + j] * __expf(gcs[i] - gcs[j]) * 0.08838834764831845f : 0.f; }
                *(u32x4*)(ws + WS_DND + (size_t)(item * 2 + d) * DND_ITEM + 8192 + (size_t)tid * 16) = (u32x4){pk2(v[0], v[1]), pk2(v[2], v[3]), pk2(v[4], v[5]), pk2(v[6], v[7])}; }
        }
    }
    __syncthreads();
    if (wave < 2) { const int d = wave; const LAS float* as = (const LAS float*)(lds + PAS) + d * 4096; float t[64];
#pragma unroll
        for (int p = 0; p < 64; ++p) { float acc = (p == lane) ? 1.0f : 0.0f;
#pragma unroll
            for (int p2 = 0; p2 < p; ++p2) acc -= as[p * 64 + p2] * t[p2];
            t[p] = acc; }
        LAS bf16* ts = (LAS bf16*)(lds + PTS) + d * 4608; const int jc = d ? 63 - lane : lane;
#pragma unroll
        for (int p = 0; p < 64; ++p) { const int i = d ? 63 - p : p; ts[i * 72 + jc] = f2bf(t[p]); } }
    __syncthreads();
    {
#pragma unroll
        for (int d = 0; d < 2; ++d) { const int mt = tid >> 7, kk = (tid >> 6) & 1, ln = tid & 63, i = 16 * mt + (ln & 15), g = ln >> 4;
            const LAS unsigned char* src = lds + PTS + d * 9216 + i * 144 + (32 * kk + 4 * g) * 2;
            const u32x2 lo = *(const LAS u32x2*)src, hi = *(const LAS u32x2*)(src + 32);
            *(u32x4*)(ws + WS_DND + (size_t)(item * 2 + d) * DND_ITEM + (size_t)tid * 16) = (u32x4){lo.x, lo.y, hi.x, hi.y}; }
    }
    __syncthreads();
}

__device__ __forceinline__ void na_prep_item(const Args& a, int l, int item, int lane) {
    unsigned char* ws = a.ws;
    const int row = item * 64 + lane;
    bf16* na = (bf16*)(ws + WS_NA) + (size_t)row * 768; bf16* vt = (bf16*)(ws + WS_VT);
    const int b = row < NLAT ? (row >> 14) : ((row - NLAT) >> 8), tpos = row < NLAT ? (row & 16383) : 16384 + ((row - NLAT) & 255);
    const float* qn = a.in[13] + l * 64; const float* kn = a.in[14] + l * 64;
#pragma unroll 1
    for (int sec = 0; sec < 2; ++sec)
#pragma unroll 1
        for (int h = 0; h < 4; ++h) { u32x4* p = (u32x4*)(na + sec * 256 + h * 64); u32x4 v[8]; float ss = 0.f;
#pragma unroll
            for (int i = 0; i < 8; ++i) { v[i] = p[i]; const unsigned w[4] = {v[i].x, v[i].y, v[i].z, v[i].w};
#pragma unroll
                for (int e = 0; e < 4; ++e) { const float x = bflo(w[e]), y = bfhi(w[e]); ss += x * x + y * y; } }
            const float sc = rsqrtf(ss * (1.0f / 64.0f) + EPS); const float* nw = sec == 0 ? qn : kn;
#pragma unroll
            for (int i = 0; i < 8; ++i) { const unsigned w[4] = {v[i].x, v[i].y, v[i].z, v[i].w}; unsigned o[4];
#pragma unroll
                for (int e = 0; e < 4; ++e) o[e] = pk2(bflo(w[e]) * sc * nw[8 * i + 2 * e], bfhi(w[e]) * sc * nw[8 * i + 2 * e + 1]);
                p[i] = (u32x4){o[0], o[1], o[2], o[3]}; } }
#pragma unroll 1
    for (int h = 0; h < 4; ++h) { const u32x4* p = (const u32x4*)(na + 512 + h * 64); bf16* dst = vt + ((size_t)(b * 4 + h) * 64) * 16640 + tpos;
#pragma unroll
        for (int i = 0; i < 8; ++i) { const u32x4 v = p[i]; const unsigned w[4] = {v.x, v.y, v.z, v.w};
#pragma unroll
            for (int e = 0; e < 4; ++e) { dst[(size_t)(8 * i + 2 * e) * 16640] = (bf16)(w[e] & 0xffffu); dst[(size_t)(8 * i + 2 * e + 1) * 16640] = (bf16)(w[e] >> 16); } } }
}

__device__ __forceinline__ void ft_stage1_item(const Args& a, int item, LAS unsigned char* lds, int tid, int wave, int lane) {
    unsigned char* ws = a.ws; const int b = item >> 7, t0 = item & 127;
    const bf16* ft = (const bf16*)(ws + WS_FT);
#pragma unroll
    for (int i = 0; i < 8; ++i) { const int p = tid + 512 * i, t1 = p >> 5, cp = p & 31;
        *(LAS u32x4*)(lds + t1 * 528 + cp * 16) = *(const u32x4*)(ft + (size_t)(b * SEQ + 128 * t1 + t0) * 256 + cp * 8); }
    __syncthreads();
    const int fr = lane & 15, g = lane >> 4, q = fr >> 2, pp = fr & 3;
    const bf16* f1 = (const bf16*)(ws + WS_F1);
    bf16x8 af[2][4];
#pragma unroll
    for (int c = 0; c < 2; ++c)
#pragma unroll
        for (int kk = 0; kk < 4; ++kk) af[c][kk] = *(const bf16x8*)(f1 + (size_t)(c * 128 + 16 * wave + fr) * 128 + 32 * kk + 8 * g);
    const f32x2* tw = (const f32x2*)(ws + WS_TWID); f32x2 twv[4];
#pragma unroll
    for (int r = 0; r < 4; ++r) twv[r] = tw[((16 * wave + 4 * g + r) * t0) & 16383];
    bf16* yb = (bf16*)(ws + WS_Y);
    const unsigned lbase = (unsigned)(size_t)(lds) + (8 * g + q) * 528 + 8 * pp;
#pragma unroll 2
    for (int nt = 0; nt < 16; ++nt) { f32x4 yr = {0.f, 0.f, 0.f, 0.f}, yi = {0.f, 0.f, 0.f, 0.f};
#pragma unroll
        for (int kk = 0; kk < 4; ++kk) { const unsigned ad = lbase + 32 * kk * 528 + 32 * nt; const bf16x8 bv = lds_tr8(ad, ad + 4 * 528);
            yr = MFMA16(af[0][kk], bv, yr); yi = MFMA16(af[1][kk], bv, yi); }
#pragma unroll
        for (int r = 0; r < 4; ++r) { const int kb = 16 * wave + 4 * g + r; const float cs = twv[r][0], sn = twv[r][1];
            const float pr = yr[r] * cs + yi[r] * sn, pi = yi[r] * cs - yr[r] * sn;
            const size_t o = ((((size_t)b * 128 + kb) * 2) * 128 + t0) * 256 + 16 * nt + fr;
            yb[o] = f2bf(pr); yb[o + 128 * 256] = f2bf(pi); } }
    __syncthreads();
}
constexpr int SC_Q = 0, SC_K = 16384, SC_KT = 32768, SC_V = 49152, SC_T = 51200, SC_QK = 59392, SC_AUX = 67584, SC_BUF = 68608, SC_RPB = 2 * SC_BUF;
__device__ __forceinline__ void scan_issue(const unsigned char* ws, int item, int d, int s, LAS unsigned char* buf, int lane) {
    const unsigned char* gs = ws + WS_DNS + (size_t)item * DNS_ITEM + lane * 16;
    const unsigned char* gd = ws + WS_DND + (size_t)(item * 2 + d) * DND_ITEM + lane * 16;
#pragma unroll 1
    for (int i = 0; i < 48; i += 4) {
#pragma unroll
        for (int j = 0; j < 4; ++j) __builtin_amdgcn_global_load_lds((const unsigned*)(gs + j * 1024), (LAS unsigned*)(buf + j * 1024), 16, 0, 0);
        gs += 4096; buf += 4096; }
    gs += s * 2048;
#pragma unroll
    for (int j = 0; j < 2; ++j) __builtin_amdgcn_global_load_lds((const unsigned*)(gs + j * 1024), (LAS unsigned*)(buf + j * 1024), 16, 0, 0);
    buf += 2048;
#pragma unroll 1
    for (int i = 0; i < 16; i += 4) {
#pragma unroll
        for (int j = 0; j < 4; ++j) __builtin_amdgcn_global_load_lds((const unsigned*)(gd + j * 1024), (LAS unsigned*)(buf + j * 1024), 16, 0, 0);
        gd += 4096; buf += 4096; }
    __builtin_amdgcn_global_load_lds((const unsigned*)gd, (LAS unsigned*)buf, 16, 0, 0);
}
__device__ __forceinline__ void scan_wave(const Args& a, int chain, int s, LAS unsigned char* lds, int lane) {
    const unsigned char* ws = a.ws;
    const int h = chain & 3, d = (chain >> 2) & 1, b = chain >> 3, fr = lane & 15, g = lane >> 4;
    bf16* obuf = (bf16*)(ws + WS_HBUF) + (size_t)d * NROW * 512;
    f32x4 S[8];
#pragma unroll
    for (int i = 0; i < 8; ++i) S[i] = (f32x4){0.f, 0.f, 0.f, 0.f};
    auto item_of = [&](int step) { const int cs = step < 4 ? (d ? 3 - step : step) : 4 + (d ? 259 - step : step - 4); return ((b * 260 + cs) << 2) + h; };
    scan_issue(ws, item_of(0), d, s, lds, lane);
#pragma unroll 1
    for (int step = 0; step < 260; ++step) {
        VM_WAIT(); LDS_WAIT();
        if (step + 1 < 260) scan_issue(ws, item_of(step + 1), d, s, lds + ((step + 1) & 1) * SC_BUF, lane);
        LAS unsigned char* bf = lds + (step & 1) * SC_BUF;
        const int cs = step < 4 ? (d ? 3 - step : step) : 4 + (d ? 259 - step : step - 4);
        const int rowbase = cs < 4 ? NLAT + b * CTXL + 64 * cs : b * SEQ + 64 * (cs - 4);
        bf16x8 Sb[4];
#pragma unroll
        for (int kk = 0; kk < 4; ++kk) Sb[kk] = pack8(S[2 * kk], S[2 * kk + 1]);
        f32x4 KS[4], QS[4];
#pragma unroll
        for (int mt = 0; mt < 4; ++mt) { KS[mt] = (f32x4){0.f, 0.f, 0.f, 0.f}; QS[mt] = (f32x4){0.f, 0.f, 0.f, 0.f};
#pragma unroll
            for (int kk = 0; kk < 4; ++kk) { const int fo = ((mt * 4 + kk) * 64 + lane) * 16;
                KS[mt] = MFMA16(*(const LAS bf16x8*)(bf + SC_K + fo), Sb[kk], KS[mt]);
                QS[mt] = MFMA16(*(const LAS bf16x8*)(bf + SC_Q + fo), Sb[kk], QS[mt]); } }
        f32x4 egc[4], ekd[4], D[4];
#pragma unroll
        for (int mt = 0; mt < 4; ++mt) { const int to = (16 * mt + 4 * g) * 4;
            const f32x4 bt = *(const LAS f32x4*)(bf + SC_AUX + to); egc[mt] = *(const LAS f32x4*)(bf + SC_AUX + 256 + to); ekd[mt] = *(const LAS f32x4*)(bf + SC_AUX + 512 + to);
            const u32x2 vv = *(const LAS u32x2*)(bf + SC_V + (mt * 64 + lane) * 8);
            const f32x4 v4 = {bflo(vv.x), bfhi(vv.x), bflo(vv.y), bfhi(vv.y)};
            D[mt] = bt * (v4 - egc[mt] * KS[mt]); }
        const float egl = *(const LAS float*)(bf + SC_AUX + 768);
        bf16x8 Db[2];
#pragma unroll
        for (int k2 = 0; k2 < 2; ++k2) Db[k2] = pack8(D[2 * k2], D[2 * k2 + 1]);
        f32x4 VN[4];
#pragma unroll
        for (int mt = 0; mt < 4; ++mt) { VN[mt] = (f32x4){0.f, 0.f, 0.f, 0.f};
#pragma unroll
            for (int k2 = 0; k2 < 2; ++k2) VN[mt] = MFMA16(*(const LAS bf16x8*)(bf + SC_T + ((mt * 2 + k2) * 64 + lane) * 16), Db[k2], VN[mt]); }
        bf16x8 Vb[2], Vd[2];
#pragma unroll
        for (int k2 = 0; k2 < 2; ++k2) { Vb[k2] = pack8(VN[2 * k2], VN[2 * k2 + 1]); Vd[k2] = pack8(ekd[2 * k2] * VN[2 * k2], ekd[2 * k2 + 1] * VN[2 * k2 + 1]); }
#pragma unroll
        for (int mt = 0; mt < 4; ++mt) { f32x4 O = egc[mt] * QS[mt] * 0.08838834764831845f;
#pragma unroll
            for (int k2 = 0; k2 < 2; ++k2) O = MFMA16(*(const LAS bf16x8*)(bf + SC_QK + ((mt * 2 + k2) * 64 + lane) * 16), Vb[k2], O);
            bf16* op = obuf + (size_t)(rowbase + 16 * mt + 4 * g) * 512 + h * 128 + 16 * s + fr;
#pragma unroll
            for (int r = 0; r < 4; ++r) op[r * 512] = f2bf(O[r]); }
#pragma unroll
        for (int dt = 0; dt < 8; ++dt) { f32x4 acc = S[dt] * egl;
#pragma unroll
            for (int k2 = 0; k2 < 2; ++k2) acc = MFMA16(*(const LAS bf16x8*)(bf + SC_KT + ((dt * 2 + k2) * 64 + lane) * 16), Vd[k2], acc);
            S[dt] = acc; }
    }
    VM_WAIT();
}

template <bool CTXQ> __device__ __forceinline__ void na_wave(const Args& a, int item, LAS unsigned char* lds, int lane) {
    const unsigned char* ws = a.ws; const int fr = lane & 15, g = lane >> 4;
    const bf16* na = (const bf16*)(ws + WS_NA); const bf16* vt = (const bf16*)(ws + WS_VT); bf16* mix = (bf16*)(ws + WS_QKV);
    int b, h, r = 0, wq = 0, qrow, r0 = 0, cw0 = 0;
    if (CTXQ) { const int qb = item & 15; h = (item >> 4) & 3; b = item >> 6; qrow = NLAT + b * CTXL + 16 * qb + fr; }
    else { wq = item & 3; r = (item >> 2) & 255; h = (item >> 10) & 3; b = item >> 12; qrow = b * SEQ + 64 * r + 16 * wq + fr;
        r0 = min(max(r - 4, 0), 248); cw0 = min(max(16 * wq - 8, 0), 32); }
    bf16x8 qf[2];
#pragma unroll
    for (int kk = 0; kk < 2; ++kk) qf[kk] = *(const bf16x8*)(na + (size_t)qrow * 768 + h * 64 + 32 * kk + 8 * g);
    constexpr int NT = CTXQ ? 16 : 32, T0 = CTXQ ? 16 : 0;
    f32x4 sc[NT];
#pragma unroll
    for (int t = 0; t < NT; ++t) { const int T = T0 + t;
        const int krow = T < 16 ? b * SEQ + (r0 + (T >> 1)) * 64 + cw0 + 16 * (T & 1) + fr : NLAT + b * CTXL + 16 * (T - 16) + fr;
        f32x4 acc = {0.f, 0.f, 0.f, 0.f};
#pragma unroll
        for (int kk = 0; kk < 2; ++kk) acc = MFMA16(*(const bf16x8*)(na + (size_t)krow * 768 + 256 + h * 64 + 32 * kk + 8 * g), qf[kk], acc);
        sc[t] = acc * (0.125f * LOG2E); if ((t & 3) == 3) __builtin_amdgcn_sched_barrier(0); }
    float mx = -3.0e38f;
    if (!CTXQ) { const LAS float* rpb = (const LAS float*)(lds + SC_RPB) + h * 465; const int qcol = 16 * wq + fr, c0 = min(max(qcol - 8, 0), 48);
#pragma unroll
        for (int t = 0; t < 16; ++t) { const int offr = r0 + (t >> 1) - r + 7;
#pragma unroll
            for (int j = 0; j < 4; ++j) { const int kc = cw0 + 16 * (t & 1) + 4 * g + j; const bool ok = kc >= c0 && kc < c0 + 16; const int offc = min(max(kc - qcol + 15, 0), 30);
                sc[t][j] = ok ? sc[t][j] + rpb[offr * 31 + offc] : -3.0e38f; } } }
#pragma unroll
    for (int t = 0; t < NT; ++t) mx = fmaxf(fmaxf(fmaxf(sc[t][0], sc[t][1]), fmaxf(sc[t][2], sc[t][3])), mx);
    mx = fmaxf(mx, __shfl_xor(mx, 16)); mx = fmaxf(mx, __shfl_xor(mx, 32));
    float sum = 0.f;
#pragma unroll
    for (int t = 0; t < NT; ++t)
#pragma unroll
        for (int j = 0; j < 4; ++j) { const float p = exp2f(sc[t][j] - mx); sc[t][j] = p; sum += p; }
    sum += __shfl_xor(sum, 16); sum += __shfl_xor(sum, 32);
    const float inv = 1.0f / sum;
    f32x4 O[4];
#pragma unroll
    for (int mt = 0; mt < 4; ++mt) O[mt] = (f32x4){0.f, 0.f, 0.f, 0.f};
    const bf16* vbase = vt + ((size_t)(b * 4 + h) * 64 + fr) * 16640;
#pragma unroll
    for (int k2 = 0; k2 < NT / 2; ++k2) { const int T = T0 + 2 * k2;
        const int tp = T < 16 ? (r0 + (T >> 1)) * 64 + cw0 + 4 * g : 16384 + 16 * (T - 16) + 4 * g;
        const bf16x8 pb = pack8(sc[2 * k2] * inv, sc[2 * k2 + 1] * inv);
#pragma unroll
        for (int mt = 0; mt < 4; ++mt) { const bf16* vp = vbase + (size_t)(16 * mt) * 16640 + tp; const u32x2 lo = *(const u32x2*)vp, hi = *(const u32x2*)(vp + 16);
            O[mt] = MFMA16(mk8(lo.x, lo.y, hi.x, hi.y), pb, O[mt]); } if ((k2 & 1) == 1) __builtin_amdgcn_sched_barrier(0); }
#pragma unroll
    for (int mt = 0; mt < 4; ++mt) { const f32x4 o = O[mt];
        *(u32x2*)(mix + (size_t)qrow * 1024 + 512 + h * 64 + 16 * mt + 4 * g) = (u32x2){pk2(o[0], o[1]), pk2(o[2], o[3])}; }
}
__device__ __forceinline__ void dn_combine(const Args& a, int l, int gw, int ngw, int lane) {
    unsigned char* ws = a.ws; const int nrow = l == 0 ? NROW : NLAT;
    const bf16* of = (const bf16*)(ws + WS_HBUF); const bf16* ob = of + (size_t)NROW * 512; const bf16* zb = (const bf16*)(ws + WS_Z); bf16* mix = (bf16*)(ws + WS_QKV);
    const float* nw = a.in[12] + l * 128 + (8 * lane & 127);
    float w[8];
#pragma unroll
    for (int e = 0; e < 8; ++e) w[e] = nw[e];
    for (int row = gw; row < nrow; row += ngw) {
        const u32x4 pf = *(const u32x4*)(of + (size_t)row * 512 + 8 * lane), pb = *(const u32x4*)(ob + (size_t)row * 512 + 8 * lane), pz = *(const u32x4*)(zb + (size_t)row * 512 + 8 * lane);
        const unsigned f[4] = {pf.x, pf.y, pf.z, pf.w}, bb[4] = {pb.x, pb.y, pb.z, pb.w}, zz[4] = {pz.x, pz.y, pz.z, pz.w};
        float o[8], ss = 0.f;
#pragma unroll
        for (int e = 0; e < 4; ++e) { o[2 * e] = bflo(f[e]) + bflo(bb[e]); o[2 * e + 1] = bfhi(f[e]) + bfhi(bb[e]); ss += o[2 * e] * o[2 * e] + o[2 * e + 1] * o[2 * e + 1]; }
        ss += __shfl_xor(ss, 1); ss += __shfl_xor(ss, 2); ss += __shfl_xor(ss, 4); ss += __shfl_xor(ss, 8);
        const float rinv = rsqrtf(ss * (1.0f / 128.0f) + EPS);
        unsigned ow[4];
#pragma unroll
        for (int e = 0; e < 4; ++e) ow[e] = pk2(o[2 * e] * rinv * w[2 * e] * silu_f(bflo(zz[e])), o[2 * e + 1] * rinv * w[2 * e + 1] * silu_f(bfhi(zz[e])));
        *(u32x4*)(mix + (size_t)row * 1024 + 8 * lane) = (u32x4){ow[0], ow[1], ow[2], ow[3]};
    }
}
__device__ __forceinline__ void ft_stage2_item(const Args& a, int l, int item, LAS unsigned char* lds, int tid, int wave, int lane) {
    unsigned char* ws = a.ws; const bool isctx = item >= 256; int b, kb;
    const bf16* src; const bf16* amat; float scale; size_t tokbase; int tokstride;
    if (!isctx) { b = item >> 7; kb = item & 127; src = (const bf16*)(ws + WS_Y) + (size_t)(b * 128 + kb) * 65536; amat = (const bf16*)(ws + WS_A2); scale = 1.0f; tokbase = (size_t)b * SEQ + kb; tokstride = 128; }
    else { b = (item - 256) >> 1; kb = (item - 256) & 1; src = (const bf16*)(ws + WS_FT) + (size_t)(NLAT + b * CTXL) * 256; amat = (const bf16*)(ws + WS_A2C) + (size_t)kb * 65536; scale = 8.0f; tokbase = (size_t)NLAT + b * CTXL + 128 * kb; tokstride = 1; }
#pragma unroll
    for (int i = 0; i < 16; ++i) { const int p = tid + 512 * i, row = p >> 5, cp = p & 31; *(LAS u32x4*)(lds + row * 528 + cp * 16) = *(const u32x4*)(src + (size_t)row * 256 + cp * 8); }
    __syncthreads();
    const int fr = lane & 15, g = lane >> 4, q = fr >> 2, pp = fr & 3;
    const unsigned lbase = (unsigned)(size_t)(lds) + (8 * g + q) * 528 + 8 * pp;
    f32x4 Z[16][2];
#pragma unroll
    for (int mt = 0; mt < 16; ++mt) { Z[mt][0] = (f32x4){0.f, 0.f, 0.f, 0.f}; Z[mt][1] = (f32x4){0.f, 0.f, 0.f, 0.f}; }
#pragma unroll 1
    for (int kk = 0; kk < 8; ++kk) {
        const bf16x8 b0 = *(const bf16x8*)(amat + (size_t)(16 * wave + fr) * 256 + 32 * kk + 8 * g), b1 = *(const bf16x8*)(amat + (size_t)(128 + 16 * wave + fr) * 256 + 32 * kk + 8 * g);
#pragma unroll
        for (int mt = 0; mt < 16; ++mt) { const unsigned ad = lbase + 32 * kk * 528 + 32 * mt; const bf16x8 av = lds_tr8(ad, ad + 4 * 528);
            Z[mt][0] = MFMA16(av, b0, Z[mt][0]); Z[mt][1] = MFMA16(av, b1, Z[mt][1]); }
    }
    bf16x8 Zb[16];
#pragma unroll
    for (int k3 = 0; k3 < 16; ++k3) { const int c = k3 >> 3, k2 = k3 & 7; Zb[k3] = pack8(Z[2 * k2][c], Z[2 * k2 + 1][c]); }
    const bf16* wft = (const bf16*)(ws + WS_WFT) + (size_t)l * 131072; bf16* mix = (bf16*)(ws + WS_QKV);
    const size_t tok = tokbase + (size_t)(16 * wave + fr) * tokstride;
#pragma unroll 2
    for (int jt = 0; jt < 16; ++jt) { f32x4 acc = {0.f, 0.f, 0.f, 0.f};
#pragma unroll
        for (int k3 = 0; k3 < 16; ++k3) acc = MFMA16(*(const bf16x8*)(wft + ((size_t)(jt * 16 + k3) * 64 + lane) * 8), Zb[k3], acc);
        acc = acc * scale;
        *(u32x2*)(mix + tok * 1024 + 768 + 16 * jt + 4 * g) = (u32x2){pk2(acc[0], acc[1]), pk2(acc[2], acc[3])}; }
    __syncthreads();
}
__global__ __launch_bounds__(512, 2) void mega(Args a0) {
    extern __shared__ __attribute__((aligned(16))) unsigned char shm[];
    cg::grid_group grid = cg::this_grid();
    const int tid0 = threadIdx.x, blk0 = blockIdx.x, nblk = gridDim.x;
    int ph = 0;
#define PH_BEGIN if (ph >= a0.lo && ph < a0.hi) { if (ph > a0.lo) { __builtin_amdgcn_fence(__ATOMIC_RELEASE, ""); grid.sync(); __builtin_amdgcn_fence(__ATOMIC_ACQUIRE, ""); } \
    int tid = tid0, blk = blk0; asm volatile("" : "+v"(tid)); asm volatile("" : "+s"(blk)); \
    Args a = a0; asm volatile("" : "+s"(a.ws)); asm volatile("" : "+s"(a.out)); \
    LAS unsigned char* lds = (LAS unsigned char*)shm; unsigned char* ws = a.ws; const float* modv = (const float*)(ws + WS_CTL + CTL_MODV); \
    const int wave = __builtin_amdgcn_readfirstlane(tid >> 6), lane = tid & 63; \
    const int gw = blk * 8 + wave, ngw = nblk * 8, gtid = blk * 512 + tid, ngt = nblk * 512; (void)gtid; (void)ngt; (void)gw; (void)ngw; (void)modv; (void)lds; (void)lane;
#define PH_END } ++ph;
    PH_BEGIN phase_prologue(a, lds, gw, ngw, wave, lane, gtid, ngt); PH_END
#pragma unroll 1
    for (int l = 0; l < 2; ++l) {
        PH_BEGIN phase_A(a, l, lds, gw, ngw, tid, lane); PH_END
        PH_BEGIN { pg8::Gemm g{(const pg8::bf16_t*)(ws + WS_HBUF), (const pg8::bf16_t*)(ws + WS_WIN) + (size_t)l * 3072 * 1024, NROW, 3072, 1024};
            pg8::StaticOrder S; S.init(NROW, 3072, nblk, blk); pg8::EpiProj E{ws}; pg8::gemm_phase<pg8::EpiProj, pg8::StaticOrder, false>(lds, g, S, E, nullptr); __syncthreads(); } PH_END
        PH_BEGIN {
            for (int it = blk; it < 2080; it += nblk) dn_prep_item(a, l, it, lds, tid, wave, lane);
            for (int it = gw; it < 520; it += ngw) na_prep_item(a, l, it, lane);
            for (int it = blk; it < 256; it += nblk) ft_stage1_item(a, it, lds, tid, wave, lane);
        } PH_END
        PH_BEGIN {
            LAS float* rpb = (LAS float*)(lds + SC_RPB);
            for (int i = tid; i < 1860; i += 512) rpb[i] = a.in[15][l * 1860 + i] * LOG2E;
            __syncthreads();
            if (blk < 128 && wave == 0) scan_wave(a, blk & 15, blk >> 4, lds, lane);
            else { const int nidx = blk < 128 ? blk * 7 + wave - 1 : 896 + (blk - 128) * 8 + wave;
#pragma unroll 1
                for (int it = nidx; it < 8192 + 128; it += 1920) { if (it < 8192) na_wave<false>(a, it, lds, lane); else if (l == 0) na_wave<true>(a, it - 8192, lds, lane); } }
            __syncthreads();
        } PH_END
        PH_BEGIN {
            dn_combine(a, l, gw, ngw, lane);
            const int nft = l == 0 ? 260 : 256;
            for (int it = blk; it < nft; it += nblk) ft_stage2_item(a, l, it, lds, tid, wave, lane);
        } PH_END
        PH_BEGIN { const int M = l == 0 ? NROW : NLAT;
            pg8::Gemm g{(const pg8::bf16_t*)(ws + WS_QKV), (const pg8::bf16_t*)(ws + WS_WOUT) + (size_t)l * 1024 * 1024, M, 1024, 1024};
            pg8::StaticOrder S; S.init(M, 1024, nblk, blk);
            pg8::EpiResid E{l == 0 ? a.in[0] : a.out, l == 0 ? a.in[2] : (const float*)(ws + WS_CTXS), a.out, (float*)(ws + WS_CTXS), modv + (size_t)l * 3 * 6144 + 2048};
            pg8::gemm_phase<pg8::EpiResid, pg8::StaticOrder, false>(lds, g, S, E, nullptr); __syncthreads(); } PH_END
        PH_BEGIN { phase_F(a, l, lds, gw, ngw, tid, lane); if (l == 1) phase_moe_convert(a, lds, gw, ngw, wave, lane); } PH_END
        if (l == 0) {
            PH_BEGIN { pg8::Gemm g{(const pg8::bf16_t*)(ws + WS_HBUF), (const pg8::bf16_t*)(ws + WS_W13), NROW, 5632, 1024};
                pg8::StaticOrder S; S.init(NROW, 5632, nblk, blk); pg8::EpiSwiglu E{(pg8::bf16_t*)(ws + WS_ACT), DFF, 0};
                pg8::gemm_phase<pg8::EpiSwiglu, pg8::StaticOrder, false>(lds, g, S, E, nullptr); __syncthreads(); } PH_END
            PH_BEGIN { pg8::Gemm g{(const pg8::bf16_t*)(ws + WS_ACT), (const pg8::bf16_t*)(ws + WS_W2), NROW, 1024, DFF};
                pg8::StaticOrder S; S.init(NROW, 1024, nblk, blk);
                pg8::EpiResid E{a.out, (const float*)(ws + WS_CTXS), a.out, (float*)(ws + WS_CTXS), modv + 5120};
                pg8::gemm_phase<pg8::EpiResid, pg8::StaticOrder, false>(lds, g, S, E, nullptr); __syncthreads(); } PH_END
        } else {
            PH_BEGIN phase_moe_assign(a, gw, lane); PH_END
#pragma unroll 1
            for (int e = 0; e < 8; ++e) {
                int ps[9]; moe_pads(a0.ws, ps);
                const int nMtot = (ps[e + 1] - ps[e]) >> 8;
#pragma unroll 1
                for (int c0 = 0; c0 < nMtot; c0 += MACT_ROWS / 256) {
                    const int mb0 = (ps[e] >> 8) + c0; const int nM = nMtot - c0 < MACT_ROWS / 256 ? nMtot - c0 : MACT_ROWS / 256;
                    PH_BEGIN { pg8::Gemm g{(const pg8::bf16_t*)(ws + WS_XB), (const pg8::bf16_t*)(ws + WS_MW13) + (size_t)e * 7168 * 1024, 0, 7168, 1024};
                        pg8::MoeOrder S{nM, 28, mb0, nblk, blk}; pg8::EpiSwiglu E{(pg8::bf16_t*)(ws + WS_MACT), DFFE, mb0 * 256};
                        pg8::gemm_phase<pg8::EpiSwiglu, pg8::MoeOrder, false>(lds, g, S, E, nullptr); __syncthreads(); } PH_END
                    PH_BEGIN { pg8::Gemm g{(const pg8::bf16_t*)(ws + WS_MACT) - (size_t)mb0 * 256 * DFFE, (const pg8::bf16_t*)(ws + WS_MW2) + (size_t)e * 1024 * DFFE, 0, 1024, DFFE};
                        pg8::MoeOrder S{nM, 4, mb0, nblk, blk}; pg8::EpiBf16Out E{(pg8::bf16_t*)(ws + WS_XB), 1024};
                        pg8::gemm_phase<pg8::EpiBf16Out, pg8::MoeOrder, false>(lds, g, S, E, nullptr); __syncthreads(); } PH_END
                }
            }
            PH_BEGIN phase_moe_combine(a, gw, ngw, lane); PH_END
        }
    }
#ifdef DBG_SRC
    __builtin_amdgcn_fence(__ATOMIC_RELEASE, ""); grid.sync(); __builtin_amdgcn_fence(__ATOMIC_ACQUIRE, "");
    { const size_t n = (size_t)NLAT * 1024; const size_t gt = (size_t)blk0 * 512 + tid0, ng = (size_t)nblk * 512;
      if (DBG_KIND == 0) { const bf16* src = (const bf16*)(a0.ws + (size_t)DBG_SRC); for (size_t i = gt; i < n; i += ng) { a0.out[i] = (float)(src[i] & 7); } }
      else { const float* src = (const float*)(a0.ws + (size_t)DBG_SRC); for (size_t i = gt; i < n; i += ng) a0.out[i] = src[i % (size_t)DBG_N]; } }
#endif
}
constexpr int N_PHASES = 1 + 9 + 7 + 1 + 16 + 1;
#ifndef DBG_HI
#define DBG_HI (1 << 30)
#endif

extern "C" void kernel_launch(void* const* d_in, const int* in_sizes, int n_in, void* d_out, int out_size, void* d_ws, size_t ws_size, hipStream_t stream) {
    static int inited = 0;
    if (!inited) {
        if (hipFuncSetAttribute((const void*)mega, hipFuncAttributeMaxDynamicSharedMemorySize, LDS_BYTES) != hipSuccess) fprintf(stderr, "kernel_launch: hipFuncSetAttribute failed\n");
        inited = 1;
    }
    (void)hipMemsetAsync((char*)d_ws + WS_CTL, 0, 1048576, stream);
    Args a{};
    for (int i = 0; i < 25; ++i) a.in[i] = (const float*)d_in[i];
    a.out = (float*)d_out; a.ws = (unsigned char*)d_ws; a.lo = 0; a.hi = DBG_HI;
#ifdef MULTI_LAUNCH
    for (int p = 0; p < DBG_HI; p += MULTI_LAUNCH) { a.lo = p; a.hi = p + MULTI_LAUNCH < DBG_HI ? p + MULTI_LAUNCH : DBG_HI;
        void* args[] = {&a};
        hipError_t e = hipLaunchCooperativeKernel((const void*)mega, dim3(256), dim3(512), args, LDS_BYTES, stream);
        if (e != hipSuccess) { fprintf(stderr, "kernel_launch: cooperative launch failed: %s\n", hipGetErrorString(e)); break; } }
#else
    void* args[] = {&a};
    hipError_t e = hipLaunchCooperativeKernel((const void*)mega, dim3(256), dim3(512), args, LDS_BYTES, stream);
    if (e != hipSuccess) fprintf(stderr, "kernel_launch: cooperative launch failed: %s\n", hipGetErrorString(e));
#endif
}
```

```cpp
#include <hip/hip_runtime.h>
#include <hip/hip_cooperative_groups.h>
#include <cstdio>
namespace cg = cooperative_groups;
#define LAS __attribute__((address_space(3)))
typedef unsigned short bf16;
typedef short bf16x8 __attribute__((ext_vector_type(8)));
typedef float f32x4 __attribute__((ext_vector_type(4)));
typedef float f32x2 __attribute__((ext_vector_type(2)));
typedef unsigned u32x4 __attribute__((ext_vector_type(4)));
typedef unsigned u32x2 __attribute__((ext_vector_type(2)));

constexpr int DM = 1024, NLAT = 32768, NCTX = 512, NROW = 33280, SEQ = 16384, CTXL = 256;
constexpr int INW = 3088, DFF = 2816, DFFE = 3584, NEXP = 8;
constexpr float EPS = 1e-6f, LOG2E = 1.4426950408889634f;
constexpr int LDS_BYTES = 155648, NWG_WAVES = 8;

constexpr size_t MB = 1048576;
constexpr size_t WS_CTL = 0;
constexpr size_t CTL_MODV = 0;
constexpr size_t CTL_CNT = 160 * 1024;
constexpr size_t WS_TWID = 1 * MB;
constexpr size_t WS_F1 = WS_TWID + 131072;
constexpr size_t WS_A2 = WS_F1 + 65536;
constexpr size_t WS_A2C = WS_A2 + 131072;
constexpr size_t WS_WFT = WS_A2C + 262144;
constexpr size_t WS_GAB = 3 * MB;
constexpr size_t WS_CTXS = 6 * MB;
constexpr size_t WS_TOK = 8 * MB;
constexpr size_t WS_WIN = 10 * MB;
constexpr size_t WS_WOUT = 22 * MB;
constexpr size_t WS_W13 = 26 * MB;
constexpr size_t WS_W2 = 37 * MB;
constexpr size_t WS_HBUF = 43 * MB;
constexpr size_t WS_QKV = 108 * MB;
constexpr size_t WS_Z = 206 * MB;
constexpr size_t WS_NA = 239 * MB;
constexpr size_t WS_FT = 288 * MB;
constexpr size_t WS_VT = 305 * MB;
constexpr size_t WS_Y = 322 * MB;
constexpr size_t WS_DNS = 354 * MB;
constexpr size_t WS_DND = 484 * MB;
constexpr size_t WS_ACT = WS_DNS;
constexpr size_t WS_MW13 = 108 * MB;
constexpr size_t WS_MW2 = 220 * MB;
constexpr size_t WS_XB = 276 * MB;
constexpr size_t WS_MACT = 408 * MB;
constexpr size_t WS_SLOT = 9 * MB;
constexpr int MACT_ROWS = 16384;
constexpr int DNS_ITEM = 65536, DND_ITEM = 17408;

typedef __bf16 bf16x2_t __attribute__((ext_vector_type(2)));
__device__ __forceinline__ unsigned pk2(float lo, float hi) { bf16x2_t v = {(__bf16)lo, (__bf16)hi}; return __builtin_bit_cast(unsigned, v); }
__device__ __forceinline__ float bflo(unsigned u) { return __uint_as_float(u << 16); }
__device__ __forceinline__ float bfhi(unsigned u) { return __uint_as_float(u & 0xffff0000u); }
__device__ __forceinline__ float bf2f(bf16 b) { return __uint_as_float(((unsigned)b) << 16); }
__device__ __forceinline__ bf16 f2bf(float f) { return (bf16)(pk2(f, 0.f) & 0xffffu); }
__device__ __forceinline__ float wave_sum(float v) {
#pragma unroll
    for (int o = 1; o < 64; o <<= 1) v += __shfl_xor(v, o);
    return v;
}
__device__ __forceinline__ float silu_f(float v) { return v / (1.f + __expf(-v)); }
__device__ __forceinline__ bf16x8 mk8(unsigned a, unsigned b, unsigned c, unsigned d) { u32x4 v = {a, b, c, d}; return __builtin_bit_cast(bf16x8, v); }
__device__ __forceinline__ bf16x8 pack8(f32x4 a, f32x4 b) { return mk8(pk2(a[0], a[1]), pk2(a[2], a[3]), pk2(b[0], b[1]), pk2(b[2], b[3])); }
#define MFMA16(a, b, c) __builtin_amdgcn_mfma_f32_16x16x32_bf16((a), (b), (c), 0, 0, 0)
#define LDS_WAIT() asm volatile("s_waitcnt lgkmcnt(0)" ::: "memory")
#define VM_WAIT() asm volatile("s_waitcnt vmcnt(0)" ::: "memory")
__device__ __forceinline__ bf16x8 lds_tr8(unsigned addr, unsigned addr2) {
    u32x2 a, b;
    asm volatile("ds_read_b64_tr_b16 %0, %2\n\tds_read_b64_tr_b16 %1, %3\n\ts_waitcnt lgkmcnt(0)" : "=&v"(a), "=&v"(b) : "v"(addr), "v"(addr2) : "memory");
    return mk8(a.x, a.y, b.x, b.y);
}

__device__ __forceinline__ u32x2 tr_issue(unsigned addr) { u32x2 r; asm volatile("ds_read_b64_tr_b16 %0, %1" : "=v"(r) : "v"(addr) : "memory"); return r; }
__device__ __forceinline__ void tr_wait8(u32x2& a, u32x2& b, u32x2& c, u32x2& d, u32x2& e, u32x2& f, u32x2& g, u32x2& h) {
    asm volatile("s_waitcnt lgkmcnt(0)" : "+v"(a), "+v"(b), "+v"(c), "+v"(d), "+v"(e), "+v"(f), "+v"(g), "+v"(h) :: "memory"); }

struct Args {
    const float* in[25];
    float* out;
    unsigned char* ws;
    int lo, hi;
};
namespace pg8 {
#define PG8_LAS __attribute__((address_space(3)))
typedef unsigned short bf16_t;
typedef short bf16x8 __attribute__((ext_vector_type(8)));
typedef float f32x4 __attribute__((ext_vector_type(4)));
typedef unsigned u32x4 __attribute__((ext_vector_type(4)));
constexpr int BM = 256, BK = 64, HALF = 128, HTB = HALF * BK * 2  , STAGE_BYTES = 8 * HTB, NXCD = 8, WGM = 8;

__host__ __device__ __forceinline__ int lds_byte(int r, int c) { const int st = (r >> 4) * 2 + (c >> 5), rr = r & 15, cc = c & 31, ob = rr * 64 + cc * 2; return st * 1024 + (ob ^ (((ob >> 9) & 1) << 5)); }
__host__ __device__ __forceinline__ void stage_rc(int b, int& R, int& C) { const int st = b / 1024, sb = b % 1024, swz = sb ^ (((sb >> 9) & 1) << 5); R = (st >> 1) * 16 + swz / 64; C = (st & 1) * 32 + (swz % 64) / 2; }
__host__ __device__ __forceinline__ int perm32(int rho) { const int n = rho >> 4, i = rho & 15; return 8 * (i >> 2) + 4 * n + (i & 3); }

struct Unit { int pm, pn; };
struct Gemm { const bf16_t* A; const bf16_t* Bt; int M, N, K; };

struct StaticOrder {
    int nM, nN, nwg, G, c;
    __host__ __device__ void init(int M, int N, int G_, int c_) { nM = M / BM; nN = N / BM; nwg = nM * nN; G = G_; c = c_; }
    __host__ __device__ bool next(int i, Unit& u) const {
        const long L = (long)i * G + c; if (L >= nwg) return false;
        int wgid = (int)L; { const int q = nwg / NXCD, r = nwg % NXCD, xcd = wgid % NXCD, off = wgid / NXCD; wgid = (xcd < r ? xcd * (q + 1) : r * (q + 1) + (xcd - r) * q) + off; }
        const int nig = WGM * nN, gid = wgid / nig, fm = gid * WGM, gsz = (nM - fm) < WGM ? (nM - fm) : WGM;
        u.pm = fm + ((wgid % nig) % gsz); u.pn = (wgid % nig) / gsz; return true;
    }
    __device__ __forceinline__ void a_ready(const Unit&) const {}
    __device__ __forceinline__ void done(const Unit&) const {}
    __device__ __forceinline__ const char* bptr(const Gemm& g, const Unit& u, size_t tstep) const { return (const char*)g.Bt + (size_t)u.pn * tstep; }
};
__device__ __forceinline__ unsigned cvt_pk_bf16(float lo, float hi) { return pk2(lo, hi); }
template <class Epi, class Sched, bool STAMP = false>
__device__ __forceinline__ void gemm_phase(PG8_LAS unsigned char* lds, const Gemm g, const Sched& S, const Epi& E, unsigned long long* stamps) {
    int tid_l = threadIdx.x; asm volatile("" : "+v"(tid_l)); const int tid = tid_l, wid = __builtin_amdgcn_readfirstlane(tid >> 6), lane = tid & 63, wr = wid >> 2, wc = wid & 3, fr = lane & 15, fq = lane >> 4;
    const int K = g.K, nt = K / BK;
    int ts_lo = 0, ts_hi = 0, nts = 0; const unsigned long long rt_entry = STAMP ? (unsigned long long)wall_clock64() : 0ull;
#define PG8_STAMP() do { if (STAMP && wid == 0 && nts < 64) { const unsigned long long _c = (unsigned long long)clock64(); \
        ts_lo = (lane == nts) ? (int)(unsigned)_c : ts_lo; ts_hi = (lane == nts) ? (int)(unsigned)(_c >> 32) : ts_hi; ++nts; } } while (0)
    PG8_STAMP();
    unsigned voffA[2], voffB[2];
#pragma unroll
    for (int i = 0; i < 2; ++i) { int R, C; stage_rc(tid * 16 + i * 8192, R, C); const int Rb = Epi::PERM ? ((R & ~31) + perm32(R & 31)) : R;
        voffA[i] = (unsigned)(R * K + C) * 2u; voffB[i] = (unsigned)(Rb * K + C) * 2u; }
    const size_t kstep = (size_t)(BK * 2);
    const size_t hstep = (size_t)HALF * K * 2;
    const size_t tstep = 2 * hstep;
    const unsigned ldsw = (unsigned)wid * 1024u;
    const int aoff = lds_byte(wr * 64 + fr, fq * 8), boff = lds_byte(wc * 32 + fr, fq * 8);
#define PG8_SA(b, h) (((b) * 2 + (h)) * HTB)
#define PG8_SB(b, h) ((4 + (b) * 2 + (h)) * HTB)
#define PG8_STAGE(bufoff, gbase, voff) do { _Pragma("unroll") for (int _i = 0; _i < 2; ++_i) \
        __builtin_amdgcn_global_load_lds((const unsigned*)((const char*)(gbase) + (voff)[_i]), (PG8_LAS unsigned*)(lds + (bufoff) + ldsw + _i * 8192), 16, 0, 0); } while (0)
#define PG8_STAGEA(bufoff, gbase, voff) do { _Pragma("unroll") for (int _i = 0; _i < 2; ++_i) \
        __builtin_amdgcn_global_load_lds((const unsigned*)((const char*)(gbase) + (voff)[_i]), (PG8_LAS unsigned*)(lds + (bufoff) + ldsw + _i * 8192), 16, 0, 16); } while (0)
#define PG8_LDA(dst, b, h) do { _Pragma("unroll") for (int m = 0; m < 4; ++m) _Pragma("unroll") for (int k = 0; k < 2; ++k) dst[m][k] = *(const PG8_LAS bf16x8*)(lds + PG8_SA(b, h) + aoff + m * 2048 + k * 1024); } while (0)
#define PG8_LDB(dst, b, h) do { _Pragma("unroll") for (int n = 0; n < 2; ++n) _Pragma("unroll") for (int k = 0; k < 2; ++k) dst[n][k] = *(const PG8_LAS bf16x8*)(lds + PG8_SB(b, h) + boff + n * 2048 + k * 1024); } while (0)
#define PG8_MMA(ai, bj, At, Bt) do { __builtin_amdgcn_s_setprio(1); _Pragma("unroll") for (int m = 0; m < 4; ++m) _Pragma("unroll") for (int n = 0; n < 2; ++n) _Pragma("unroll") for (int k = 0; k < 2; ++k) \
        acc[ai][bj][m][n] = __builtin_amdgcn_mfma_f32_16x16x32_bf16(Bt[n][k], At[m][k], acc[ai][bj][m][n], 0, 0, 0); __builtin_amdgcn_s_setprio(0); } while (0)
#define PG8_WAIT_V(n) asm volatile("s_waitcnt vmcnt(" #n ")" ::: "memory")
#define PG8_WAIT_L(n) asm volatile("s_waitcnt lgkmcnt(" #n ")" ::: "memory")
#define PG8_BAR __builtin_amdgcn_s_barrier()
#define PG8_SCHED __builtin_amdgcn_sched_barrier(0)
    Unit cur, nxt; int ui = 0;
    if (!S.next(0, cur)) return;
    f32x4 acc[2][2][4][2];
#pragma unroll
    for (int a = 0; a < 2; ++a)
#pragma unroll
        for (int b = 0; b < 2; ++b)
#pragma unroll
            for (int m = 0; m < 4; ++m)
#pragma unroll
                for (int n = 0; n < 2; ++n) acc[a][b][m][n] = (f32x4){0.f, 0.f, 0.f, 0.f};
    bf16x8 At[4][2], B0[2][2], B1[2][2];
    const char* cA = (const char*)g.A + (size_t)cur.pm * tstep; const char* cB = S.bptr(g, cur, tstep);
    S.a_ready(cur);
    PG8_STAGE(PG8_SB(0, 0), cB, voffB); PG8_STAGEA(PG8_SA(0, 0), cA, voffA); PG8_STAGE(PG8_SB(0, 1), cB + hstep, voffB); PG8_STAGEA(PG8_SA(0, 1), cA + hstep, voffA);
    if (wr == 1) PG8_BAR;
    PG8_WAIT_V(4); PG8_BAR;
    PG8_STAGE(PG8_SB(1, 0), cB + kstep, voffB); PG8_STAGEA(PG8_SA(1, 0), cA + kstep, voffA); PG8_STAGE(PG8_SB(1, 1), cB + hstep + kstep, voffB);
    PG8_WAIT_V(6); PG8_BAR;
    PG8_STAMP();
    for (;;) {
        const bool has_next = S.next(ui + 1, nxt);
        const char* nA = has_next ? (const char*)g.A + (size_t)nxt.pm * tstep : cA; const char* nB = has_next ? S.bptr(g, nxt, tstep) : cB;
        for (int t = 0; t < nt; t += 2) {
            const bool last = (t == nt - 2);
            const char* a1 = cA + (size_t)(t + 1) * kstep;
            const char* a2 = last ? nA : cA + (size_t)(t + 2) * kstep; const char* b2 = last ? nB : cB + (size_t)(t + 2) * kstep;
            const char* a3 = a2 + kstep; const char* b3 = b2 + kstep;
            if (last && has_next) S.a_ready(nxt);
            PG8_LDB(B0, 0, 0); PG8_SCHED; PG8_LDA(At, 0, 0); PG8_STAGEA(PG8_SA(1, 1), a1 + hstep, voffA);
            PG8_WAIT_L(8); PG8_BAR; PG8_WAIT_L(0); PG8_MMA(0, 0, At, B0); PG8_BAR; PG8_SCHED;
            PG8_LDB(B1, 0, 1); PG8_STAGE(PG8_SB(0, 0), b2, voffB);
            PG8_BAR; PG8_WAIT_L(0); PG8_MMA(0, 1, At, B1); PG8_BAR;
            PG8_LDA(At, 0, 1); PG8_STAGEA(PG8_SA(0, 0), a2, voffA);
            PG8_BAR; PG8_WAIT_L(0); PG8_MMA(1, 0, At, B0); PG8_BAR; PG8_SCHED;
            PG8_STAGE(PG8_SB(0, 1), b2 + hstep, voffB);
            PG8_WAIT_V(6); PG8_BAR; PG8_MMA(1, 1, At, B1); PG8_BAR;
            PG8_LDB(B0, 1, 0); PG8_SCHED; PG8_LDA(At, 1, 0); PG8_STAGEA(PG8_SA(0, 1), a2 + hstep, voffA);
            PG8_WAIT_L(8); PG8_BAR; PG8_WAIT_L(0); PG8_MMA(0, 0, At, B0); PG8_BAR; PG8_SCHED;
            PG8_LDB(B1, 1, 1); PG8_STAGE(PG8_SB(1, 0), b3, voffB);
            PG8_BAR; PG8_WAIT_L(0); PG8_MMA(0, 1, At, B1); PG8_BAR;
            PG8_LDA(At, 1, 1); PG8_STAGEA(PG8_SA(1, 0), a3, voffA);
            PG8_BAR; PG8_WAIT_L(0); PG8_MMA(1, 0, At, B0); PG8_BAR; PG8_SCHED;
            PG8_STAGE(PG8_SB(1, 1), b3 + hstep, voffB);
            PG8_WAIT_V(6); PG8_BAR; PG8_MMA(1, 1, At, B1); PG8_BAR;
        }
        PG8_STAMP();
        if constexpr (!Epi::AFTER_DRAIN) { E(acc, cur, wr, wc, fr, fq); S.done(cur); }
        PG8_STAMP();
        if (!has_next) break;
#pragma unroll
        for (int a = 0; a < 2; ++a)
#pragma unroll
            for (int b = 0; b < 2; ++b)
#pragma unroll
                for (int m = 0; m < 4; ++m)
#pragma unroll
                    for (int n = 0; n < 2; ++n) acc[a][b][m][n] = (f32x4){0.f, 0.f, 0.f, 0.f};
        cur = nxt; cA = nA; cB = nB; ++ui;
    }
    PG8_WAIT_V(0);
    if (wr == 0) PG8_BAR;
    PG8_BAR;
    if constexpr (Epi::AFTER_DRAIN) { E.fused(acc, cur, wr, wc, fr, fq, lds, wid, lane); S.done(cur); }
    PG8_STAMP();
    if (STAMP && wid == 0) { stamps[lane] = lane < nts ? (((unsigned long long)(unsigned)ts_hi << 32) | (unsigned)ts_lo) : 0ull;
        if (lane == 62) stamps[62] = rt_entry; if (lane == 63) stamps[63] = (unsigned long long)wall_clock64(); }
#undef PG8_STAMP
#undef PG8_SA
#undef PG8_SB
#undef PG8_STAGE
#undef PG8_STAGEA
#undef PG8_LDA
#undef PG8_LDB
#undef PG8_MMA
#undef PG8_WAIT_V
#undef PG8_WAIT_L
#undef PG8_BAR
#undef PG8_SCHED
}
}
#define XB_TMO      128
#define XB_XCNT(j)  (256  + 64 * (j))
#define XB_XSUB(j)  (1280 + 64 * (j))
#define XB_XGEN(j)  (2304 + 64 * (j))
#define XB_TOP      3328
#define XB_TOPGEN   3392
#define XCD_BAR_WORDS 3456
#define XB_SPIN_CAP (1u << 18)

__device__ __forceinline__ unsigned xb_ld(unsigned* p)              { return __hip_atomic_load(p, __ATOMIC_RELAXED, __HIP_MEMORY_SCOPE_AGENT); }
__device__ __forceinline__ unsigned xb_add(unsigned* p, unsigned v) { return __hip_atomic_fetch_add(p, v, __ATOMIC_RELAXED, __HIP_MEMORY_SCOPE_AGENT); }
__device__ __forceinline__ unsigned xb_xcc_id() { return (unsigned)__builtin_amdgcn_s_getreg((3 << 11) | 20) & 0xFu; }
#define XB_SPIN(cond, bar) do { unsigned _sp = 0; while (cond) { __builtin_amdgcn_s_sleep(1); \
    if ((++_sp & 255u) == 0u) { if (xb_ld(&(bar)[XB_TMO])) break; if (_sp > XB_SPIN_CAP) { atomicAdd(&(bar)[XB_TMO], 1u); break; } } } } while (0)

struct XcdBarrier {
    unsigned* bar; unsigned x;
    volatile LAS unsigned* st;
};

__device__ __forceinline__ XcdBarrier xcd_barrier_post(unsigned* bar, volatile LAS unsigned* st) {
    XcdBarrier b; b.bar = bar; b.x = xb_xcc_id(); b.st = st;
    if (threadIdx.x == 0) (void)xb_add(&bar[XB_XCNT(b.x)], 1u);
    return b;
}
__device__ __forceinline__ void xcd_barrier_complete(unsigned* bar, unsigned x, unsigned& nloc, unsigned& nx) {
    const unsigned G = gridDim.x * gridDim.y * gridDim.z;
    unsigned sum, cnt, mine, sp = 0u;
    for (;;) {
        sum = 0u; cnt = 0u; mine = 0u;
#pragma unroll
        for (unsigned j = 0; j < 16; ++j) { const unsigned c = xb_ld(&bar[XB_XCNT(j)]); sum += c; cnt += (c > 0u) ? 1u : 0u; mine = (j == x) ? c : mine; }
        if (sum == G) break;
        __builtin_amdgcn_s_sleep(1);
        if ((++sp & 255u) == 0u) { if (xb_ld(&bar[XB_TMO])) break; if (sp > XB_SPIN_CAP) { atomicAdd(&bar[XB_TMO], 1u); break; } }
    }
    nloc = mine > 0u ? mine : 1u; nx = cnt > 0u ? cnt : 1u;
}

__device__ __forceinline__ void xcd_barrier(const XcdBarrier& b) {
    asm volatile("s_waitcnt vmcnt(0)" ::: "memory");
    __syncthreads();
    if (threadIdx.x == 0) {
        unsigned* bar = b.bar;
        __builtin_amdgcn_s_waitcnt(0);
        unsigned nloc = b.st[0], nx = b.st[1];
        if (nloc == 0u) { xcd_barrier_complete(bar, b.x, nloc, nx); b.st[0] = nloc; b.st[1] = nx; }
        const unsigned old = xb_add(&bar[XB_XSUB(b.x)], 1u);
        const unsigned gen = old / nloc;
        if (old + 1u == (gen + 1u) * nloc) {
            __builtin_amdgcn_fence(__ATOMIC_RELEASE, "agent");
            asm volatile("s_waitcnt vmcnt(0)" ::: "memory");
            const unsigned og = xb_add(&bar[XB_TOP], 1u);
            const unsigned tg = og / nx;
            if (og + 1u == (tg + 1u) * nx) xb_add(&bar[XB_TOPGEN], 1u);
            else XB_SPIN(xb_ld(&bar[XB_TOPGEN]) == tg, bar);
            __builtin_amdgcn_fence(__ATOMIC_ACQUIRE, "agent");
            xb_add(&bar[XB_XGEN(b.x)], 1u);
            asm volatile("s_waitcnt vmcnt(0)" ::: "memory");
        } else {
            XB_SPIN(xb_ld(&bar[XB_XGEN(b.x)]) == gen, bar);
            __builtin_amdgcn_fence(__ATOMIC_ACQUIRE, "agent");
            asm volatile("s_waitcnt vmcnt(0)" ::: "memory");
        }
    }
    __syncthreads();
}

__device__ __forceinline__ void tr_item(const float* W, int ldn, int k0, int nsrc0, bf16* dst, int ldk, LAS float* scr, int lane) {
    const int r = lane >> 4, c4 = lane & 15;
    f32x4 v[16];
#pragma unroll
    for (int i = 0; i < 16; ++i) v[i] = __builtin_nontemporal_load((const f32x4*)(W + (size_t)(k0 + 4 * i + r) * ldn + nsrc0 + 4 * c4));
#pragma unroll
    for (int i = 0; i < 16; ++i) { LAS float* d = scr + (4 * i + r) * 65 + 4 * c4; d[0] = v[i][0]; d[1] = v[i][1]; d[2] = v[i][2]; d[3] = v[i][3]; }
    LDS_WAIT();
    const int c = lane & 7;
#pragma unroll
    for (int j = 0; j < 8; ++j) { const int n = (lane >> 3) + 8 * j; const LAS float* s = scr + (8 * c) * 65 + n;
        u32x4 o; o.x = pk2(s[0 * 65], s[1 * 65]); o.y = pk2(s[2 * 65], s[3 * 65]); o.z = pk2(s[4 * 65], s[5 * 65]); o.w = pk2(s[6 * 65], s[7 * 65]);
        *(u32x4*)(dst + (size_t)n * ldk + k0 + 8 * c) = o; }
    LDS_WAIT();
}
__device__ __forceinline__ int w13_row(int f) { return 256 * (f >> 7) + (f & 127); }

__device__ __forceinline__ void phase_prologue(const Args& a, LAS unsigned char* lds, int gw, int ngw, int wave, int lane, int gtid, int ngt) {
    unsigned char* ws = a.ws;
    LAS float* scr = (LAS float*)(lds + wave * 16640);
    constexpr int N_GEMV = 1536, I_WIN = 768, I_WOUT = 256, I_W1 = 704, I_W2 = 704;
    constexpr int N_ITEMS = N_GEMV + 2 * I_WIN + 2 * I_WOUT + 2 * I_W1 + I_W2;
    { LAS float* sl = (LAS float*)(lds + 133120);
        for (int i = threadIdx.x; i < 3072; i += 512) { const float v = i < 2048 ? a.in[1][i] : a.in[3][i - 2048]; sl[i] = silu_f(v); }
        __syncthreads(); }
    for (int it = gw; it < N_ITEMS; it += ngw) {
        int r = it;
        if (r < N_GEMV) {
            const int grp = r >> 3, kq = r & 7, l = grp / 96, cb = grp % 96, col = 64 * cb + lane;
            const float* wm = a.in[4] + (size_t)l * 1024 * 6144 + (size_t)(128 * kq) * 6144 + col;
            const LAS float* sl = (const LAS float*)(lds + 133120) + 128 * kq;
            float a0[4] = {0.f, 0.f, 0.f, 0.f}, a1[4] = {0.f, 0.f, 0.f, 0.f}, a2[4] = {0.f, 0.f, 0.f, 0.f};
#pragma unroll 4
            for (int k = 0; k < 128; k += 4) {
#pragma unroll
                for (int u = 0; u < 4; ++u) { const float w = wm[(size_t)(k + u) * 6144];
                    a0[u] += sl[k + u] * w; a1[u] += sl[1024 + k + u] * w; a2[u] += sl[2048 + k + u] * w; }
            }
            float* part = (float*)(ws + WS_GAB) + (size_t)r * 192;
            part[lane] = (a0[0] + a0[1]) + (a0[2] + a0[3]); part[64 + lane] = (a1[0] + a1[1]) + (a1[2] + a1[3]); part[128 + lane] = (a2[0] + a2[1]) + (a2[2] + a2[3]);
            __builtin_amdgcn_fence(__ATOMIC_RELEASE, "agent");
            unsigned old = 0; if (lane == 0) old = __hip_atomic_fetch_add((unsigned*)(ws + WS_CTL + 540672) + grp, 1u, __ATOMIC_RELAXED, __HIP_MEMORY_SCOPE_AGENT);
            old = __shfl(old, 0);
            if (old == 7u) { __builtin_amdgcn_fence(__ATOMIC_ACQUIRE, "agent");
                const float* pg = (const float*)(ws + WS_GAB) + (size_t)grp * 8 * 192; const float b = a.in[5][l * 6144 + col];
                float s0 = 0.f, s1 = 0.f, s2 = 0.f;
#pragma unroll
                for (int q = 0; q < 8; ++q) { s0 += __hip_atomic_load(pg + q * 192 + lane, __ATOMIC_RELAXED, __HIP_MEMORY_SCOPE_AGENT); s1 += __hip_atomic_load(pg + q * 192 + 64 + lane, __ATOMIC_RELAXED, __HIP_MEMORY_SCOPE_AGENT); s2 += __hip_atomic_load(pg + q * 192 + 128 + lane, __ATOMIC_RELAXED, __HIP_MEMORY_SCOPE_AGENT); }
                float* mv = (float*)(ws + WS_CTL + CTL_MODV) + (size_t)l * 3 * 6144 + col;
                mv[0] = s0 + b; mv[6144] = s1 + b; mv[2 * 6144] = s2 + b; }
            continue;
        }
        r -= N_GEMV;
        if (r < 2 * I_WIN) { const int l = r / I_WIN, q = r % I_WIN, kb = q / 48, nb = q % 48, n0 = 64 * nb;
            tr_item(a.in[8] + (size_t)l * 1024 * INW, INW, 64 * kb, n0 + (n0 >= 2048 ? 16 : 0), (bf16*)(ws + WS_WIN) + ((size_t)l * 3072 + n0) * 1024, 1024, scr, lane); continue; }
        r -= 2 * I_WIN;
        if (r < 2 * I_WOUT) { const int l = r / I_WOUT, q = r % I_WOUT, kb = q / 16, nb = q % 16;
            tr_item(a.in[17] + (size_t)l * 1024 * 1024, 1024, 64 * kb, 64 * nb, (bf16*)(ws + WS_WOUT) + ((size_t)l * 1024 + 64 * nb) * 1024, 1024, scr, lane); continue; }
        r -= 2 * I_WOUT;
        if (r < 2 * I_W1) { const int which = r / I_W1, q = r % I_W1, kb = q / 44, nb = q % 44;
            tr_item(a.in[which ? 19 : 18], DFF, 64 * kb, 64 * nb, (bf16*)(ws + WS_W13) + (size_t)(w13_row(64 * nb) + 128 * which) * 1024, 1024, scr, lane); continue; }
        r -= 2 * I_W1;
        { const int kb = r / 16, nb = r % 16;
            tr_item(a.in[20], 1024, 64 * kb, 64 * nb, (bf16*)(ws + WS_W2) + (size_t)(64 * nb) * DFF, DFF, scr, lane); }
    }
    for (int i = gtid; i < 16384; i += ngt) { float s, c; sincospif((float)i * (1.0f / 8192.0f), &s, &c); ((f32x2*)(ws + WS_TWID))[i] = (f32x2){c, s}; }
    for (int i = gtid; i < 32768; i += ngt) { const int row = i >> 7, t1 = i & 127, c = row >> 7, kb = row & 127; const float ang = (float)((kb * t1) & 127) * (1.0f / 64.0f);
        ((bf16*)(ws + WS_F1))[i] = f2bf(c == 0 ? cospif(ang) : -sinpif(ang)); }
    for (int i = gtid; i < 65536; i += ngt) { const int row = i >> 8, col = i & 255, c = row >> 7, ka = row & 127, c2 = col >> 7, t0 = col & 127; const float ang = (float)((ka * t0) & 127) * (1.0f / 64.0f);
        const float cs = cospif(ang), sn = sinpif(ang); ((bf16*)(ws + WS_A2))[i] = f2bf(c == c2 ? cs : (c == 0 ? sn : -sn)); }
    for (int i = gtid; i < 131072; i += ngt) { const int kh = i >> 16, row = (i >> 8) & 255, t = i & 255, c = row >> 7, ka = row & 127, k = 128 * kh + ka; const float ang = (float)((k * t) & 255) * (1.0f / 128.0f);
        ((bf16*)(ws + WS_A2C))[i] = f2bf(c == 0 ? cospif(ang) : -sinpif(ang)); }
    for (int i = gtid; i < 262144; i += ngt) { const int l = i >> 17, mt = (i >> 13) & 15, kk = (i >> 9) & 15, ln = (i >> 3) & 63, e = i & 7;
        const int j = 16 * mt + (ln & 15), g = ln >> 4, kidx = 32 * kk + (e < 4 ? 4 * g + e : 16 + 4 * g + e - 4), c = kidx >> 8, ch = kidx & 255, grp = ch >> 6, n = ch & 63;
        const float* fw = a.in[16] + (size_t)l * 65536 + (size_t)(grp * 64) * 256 + j; float s = 0.f;
        for (int m = 0; m < 64; ++m) { const float ang = (float)((m * n) & 63) * (1.0f / 32.0f); s += (c == 0 ? cospif(ang) : sinpif(ang)) * fw[m * 256]; }
        ((bf16*)(ws + WS_WFT))[i] = f2bf(s * (1.0f / 1024.0f)); }
}

__device__ __forceinline__ void phase_A(const Args& a, int l, LAS unsigned char* lds, int gw, int ngw, int tid, int lane) {
    unsigned char* ws = a.ws;
    LAS float* wab = (LAS float*)lds;
    const float* win = a.in[8] + (size_t)l * 1024 * INW + 2048;
    for (int i = tid; i < 16384; i += 512) { const int k = i >> 4, o = i & 15; wab[o * 1024 + k] = win[(size_t)k * INW + o]; }
    __syncthreads();
    const float* gm = a.in[6] + l * 1024;
    const float* modv = (const float*)(ws + WS_CTL + CTL_MODV) + (size_t)l * 3 * 6144;
    const float* xl = l == 0 ? a.in[0] : a.out; const float* xc = l == 0 ? a.in[2] : (const float*)(ws + WS_CTXS);
    bf16* hb = (bf16*)(ws + WS_HBUF); float* gab = (float*)(ws + WS_GAB);
    f32x4 nv[4];
    { const int row = gw < NROW ? gw : 0; const float* xr = row < NLAT ? xl + (size_t)row * 1024 : xc + (size_t)(row - NLAT) * 1024;
#pragma unroll
        for (int j = 0; j < 4; ++j) nv[j] = *(const f32x4*)(xr + 4 * lane + 256 * j); }
    for (int row = gw; row < NROW; row += ngw) {
        const int bi = row < NLAT ? (row >> 14) : 2; const float* md = modv + bi * 6144;
        f32x4 v[4]; float ss = 0.f;
#pragma unroll
        for (int j = 0; j < 4; ++j) v[j] = nv[j];
        { const int rn = row + ngw < NROW ? row + ngw : row; const float* xn = rn < NLAT ? xl + (size_t)rn * 1024 : xc + (size_t)(rn - NLAT) * 1024;
#pragma unroll
            for (int j = 0; j < 4; ++j) nv[j] = *(const f32x4*)(xn + 4 * lane + 256 * j); }
#pragma unroll
        for (int j = 0; j < 4; ++j) ss += (v[j][0] * v[j][0] + v[j][1] * v[j][1]) + (v[j][2] * v[j][2] + v[j][3] * v[j][3]);
        const float rinv = rsqrtf(wave_sum(ss) * (1.0f / 1024.0f) + EPS);
        float p[16];
#pragma unroll
        for (int o = 0; o < 16; ++o) p[o] = 0.f;
#pragma unroll
        for (int j = 0; j < 4; ++j) { const int k = 4 * lane + 256 * j; const f32x4 g4 = *(const f32x4*)(gm + k), sc = *(const f32x4*)(md + 1024 + k), sh = *(const f32x4*)(md + k);
            f32x4 h = v[j] * rinv * g4 * (sc + 1.0f) + sh; v[j] = h;
            *(u32x2*)(hb + (size_t)row * 1024 + k) = (u32x2){pk2(h[0], h[1]), pk2(h[2], h[3])};
#pragma unroll
            for (int o = 0; o < 16; ++o) { const f32x4 w4 = *(const LAS f32x4*)(wab + o * 1024 + k); p[o] += (h[0] * w4[0] + h[1] * w4[1]) + (h[2] * w4[2] + h[3] * w4[3]); } }
        float mine = 0.f;
#pragma unroll
        for (int o = 0; o < 16; ++o) { const float s = wave_sum(p[o]); if (lane == o) mine = s; }
        if (lane < 8) { const float al = mine + a.in[11][l * 8 + lane]; const float sp = fmaxf(al, 0.f) + log1pf(__expf(-fabsf(al)));
            gab[(size_t)row * 16 + lane] = -__expf(a.in[10][l * 8 + lane]) * sp; }
        else if (lane < 16) gab[(size_t)row * 16 + lane] = 1.0f / (1.0f + __expf(-mine));
    }
    __syncthreads();
}
__device__ __forceinline__ void phase_F(const Args& a, int l, LAS unsigned char* lds, int gw, int ngw, int tid, int lane) {
    unsigned char* ws = a.ws;
    LAS float* wrt = (LAS float*)lds;
    if (l == 1) { for (int i = tid; i < 8192; i += 512) { const int k = i >> 3, e = i & 7; wrt[e * 1024 + k] = a.in[21][i]; } __syncthreads(); }
    const float* gm = a.in[7] + l * 1024;
    const float* modv = (const float*)(ws + WS_CTL + CTL_MODV) + (size_t)l * 3 * 6144;
    const float* xl = a.out; const float* xc = (const float*)(ws + WS_CTXS);
    bf16* hb = (bf16*)(ws + WS_HBUF);
    int* tok_e = (int*)(ws + WS_TOK); float* tok_w = (float*)(ws + WS_TOK + 262144);
    const int nrow = l == 0 ? NROW : NLAT; int mycnt = 0;
    const int per = (nrow + ngw - 1) / ngw;
    f32x4 nv[4];
    { const int row = gw * per < nrow ? gw * per : 0; const float* xr = row < NLAT ? xl + (size_t)row * 1024 : xc + (size_t)(row - NLAT) * 1024;
#pragma unroll
        for (int j = 0; j < 4; ++j) nv[j] = *(const f32x4*)(xr + 4 * lane + 256 * j); }
    for (int row = gw * per; row < gw * per + per && row < nrow; ++row) {
        const int bi = row < NLAT ? (row >> 14) : 2; const float* md = modv + bi * 6144;
        f32x4 v[4]; float ss = 0.f;
#pragma unroll
        for (int j = 0; j < 4; ++j) v[j] = nv[j];
        { const int rn = row + 1 < nrow ? row + 1 : row; const float* xn = rn < NLAT ? xl + (size_t)rn * 1024 : xc + (size_t)(rn - NLAT) * 1024;
#pragma unroll
            for (int j = 0; j < 4; ++j) nv[j] = *(const f32x4*)(xn + 4 * lane + 256 * j); }
#pragma unroll
        for (int j = 0; j < 4; ++j) ss += (v[j][0] * v[j][0] + v[j][1] * v[j][1]) + (v[j][2] * v[j][2] + v[j][3] * v[j][3]);
        const float rinv = rsqrtf(wave_sum(ss) * (1.0f / 1024.0f) + EPS);
        float p[8];
#pragma unroll
        for (int o = 0; o < 8; ++o) p[o] = 0.f;
#pragma unroll
        for (int j = 0; j < 4; ++j) { const int k = 4 * lane + 256 * j; const f32x4 g4 = *(const f32x4*)(gm + k), sc = *(const f32x4*)(md + 4096 + k), sh = *(const f32x4*)(md + 3072 + k);
            const f32x4 h = v[j] * rinv * g4 * (sc + 1.0f) + sh;
            *(u32x2*)(hb + (size_t)row * 1024 + k) = (u32x2){pk2(h[0], h[1]), pk2(h[2], h[3])};
            if (l == 1) {
#pragma unroll
                for (int o = 0; o < 8; ++o) { const f32x4 w4 = *(const LAS f32x4*)(wrt + o * 1024 + k); p[o] += (h[0] * w4[0] + h[1] * w4[1]) + (h[2] * w4[2] + h[3] * w4[3]); } } }
        if (l == 1) {
            float lg[8];
#pragma unroll
            for (int o = 0; o < 8; ++o) lg[o] = wave_sum(p[o]);
            int e0 = 0; float l0 = lg[0];
#pragma unroll
            for (int o = 1; o < 8; ++o) if (lg[o] > l0) { l0 = lg[o]; e0 = o; }
            int e1 = -1; float l1 = -3.0e38f;
#pragma unroll
            for (int o = 0; o < 8; ++o) if (o != e0 && lg[o] > l1) { l1 = lg[o]; e1 = o; }
            const float w1 = 1.0f / (1.0f + __expf(l0 - l1)), w0 = 1.0f - w1;
            if (lane == 0) { tok_e[2 * row] = e0; tok_e[2 * row + 1] = e1; tok_w[2 * row] = w0; tok_w[2 * row + 1] = w1; }
            mycnt += (lane == e0) + (lane == e1);
        }
    }
    if (l == 1 && lane < 8 && mycnt > 0) atomicAdd((int*)(ws + WS_CTL + CTL_CNT) + lane, mycnt);
    if (l == 1 && lane < 8) ((int*)(ws + WS_CTL + 262144))[gw * 8 + lane] = mycnt;
    __syncthreads();
}
namespace pg8 {
struct EpiProj {
    static constexpr bool PERM = true, AFTER_DRAIN = false; unsigned char* ws;
    __device__ __forceinline__ void operator()(const f32x4 (&acc)[2][2][4][2], const Unit& u, int wr, int wc, int fr, int fq) const {
        const int row0 = u.pm * BM + wr * 64 + fr, pn = u.pn; bf16_t* base; int ldc, colt;
        if (pn < 6) { base = (bf16_t*)(ws + WS_QKV); ldc = 1536; colt = pn * 256; } else if (pn < 8) { base = (bf16_t*)(ws + WS_Z); ldc = 512; colt = (pn - 6) * 256; }
        else if (pn < 11) { base = (bf16_t*)(ws + WS_NA); ldc = 768; colt = (pn - 8) * 256; } else { base = (bf16_t*)(ws + WS_FT); ldc = 256; colt = 0; }
        const int col0 = colt + wc * 32 + 8 * fq;
#pragma unroll
        for (int ai = 0; ai < 2; ++ai)
#pragma unroll
            for (int m = 0; m < 4; ++m) { bf16_t* rowp = base + (size_t)(row0 + ai * HALF + m * 16) * ldc + col0;
#pragma unroll
                for (int bj = 0; bj < 2; ++bj) { const f32x4 v0 = acc[ai][bj][m][0], v1 = acc[ai][bj][m][1];
                    u32x4 w; w.x = cvt_pk_bf16(v0[0], v0[1]); w.y = cvt_pk_bf16(v0[2], v0[3]); w.z = cvt_pk_bf16(v1[0], v1[1]); w.w = cvt_pk_bf16(v1[2], v1[3]);
                    *(u32x4*)(rowp + bj * HALF) = w; } }
    }
};
struct EpiResid {
    static constexpr bool PERM = false, AFTER_DRAIN = false;
    const float* src_lat; const float* src_ctx; float* dst_lat; float* dst_ctx; const float* gate;
    __device__ __forceinline__ void operator()(const f32x4 (&acc)[2][2][4][2], const Unit& u, int wr, int wc, int fr, int fq) const {
        const int row0 = u.pm * BM + wr * 64 + fr, col0 = u.pn * BM + wc * 32 + 4 * fq;
#pragma unroll
        for (int ai = 0; ai < 2; ++ai)
#pragma unroll
            for (int m = 0; m < 4; ++m) { const int row = row0 + ai * HALF + m * 16; const bool lat = row < NLAT; const size_t ro = lat ? (size_t)row * 1024 : (size_t)(row - NLAT) * 1024;
                const float* s = (lat ? src_lat : src_ctx) + ro + col0; float* d = (lat ? dst_lat : dst_ctx) + ro + col0; const float* g = gate + (lat ? (row >> 14) : 2) * 6144 + col0;
#pragma unroll
                for (int bj = 0; bj < 2; ++bj)
#pragma unroll
                    for (int n = 0; n < 2; ++n) { const int o = bj * HALF + n * 16; *(f32x4*)(d + o) = *(const f32x4*)(s + o) + *(const f32x4*)(g + o) * acc[ai][bj][m][n]; } }
    }
};
struct EpiSwiglu {
    static constexpr bool PERM = true, AFTER_DRAIN = false; bf16_t* act; int ldc; int row_off;
    __device__ __forceinline__ void operator()(const f32x4 (&acc)[2][2][4][2], const Unit& u, int wr, int wc, int fr, int fq) const {
        const int row0 = u.pm * BM - row_off + wr * 64 + fr, col0 = u.pn * HALF + wc * 32 + 8 * fq;
#pragma unroll
        for (int ai = 0; ai < 2; ++ai)
#pragma unroll
            for (int m = 0; m < 4; ++m) { bf16_t* rowp = act + (size_t)(row0 + ai * HALF + m * 16) * ldc + col0;
                float o[8];
#pragma unroll
                for (int n = 0; n < 2; ++n)
#pragma unroll
                    for (int i = 0; i < 4; ++i) { const float x = acc[ai][0][m][n][i], y = acc[ai][1][m][n][i]; o[4 * n + i] = x / (1.0f + __expf(-x)) * y; }
                u32x4 w; w.x = cvt_pk_bf16(o[0], o[1]); w.y = cvt_pk_bf16(o[2], o[3]); w.z = cvt_pk_bf16(o[4], o[5]); w.w = cvt_pk_bf16(o[6], o[7]);
                *(u32x4*)rowp = w; }
    }
};
struct EpiBf16Out {
    static constexpr bool PERM = true, AFTER_DRAIN = false; bf16_t* O; int ldc;
    __device__ __forceinline__ void operator()(const f32x4 (&acc)[2][2][4][2], const Unit& u, int wr, int wc, int fr, int fq) const {
        const int row0 = u.pm * BM + wr * 64 + fr, col0 = u.pn * BM + wc * 32 + 8 * fq;
#pragma unroll
        for (int ai = 0; ai < 2; ++ai)
#pragma unroll
            for (int m = 0; m < 4; ++m) { bf16_t* rowp = O + (size_t)(row0 + ai * HALF + m * 16) * ldc + col0;
#pragma unroll
                for (int bj = 0; bj < 2; ++bj) { const f32x4 v0 = acc[ai][bj][m][0], v1 = acc[ai][bj][m][1];
                    u32x4 w; w.x = cvt_pk_bf16(v0[0], v0[1]); w.y = cvt_pk_bf16(v0[2], v0[3]); w.z = cvt_pk_bf16(v1[0], v1[1]); w.w = cvt_pk_bf16(v1[2], v1[3]);
                    *(u32x4*)(rowp + bj * HALF) = w; } }
    }
};
struct MoeOrder {
    int nM, nN, mb0, G, c; int ps[8]; size_t estride;
    __device__ __forceinline__ bool next(int i, Unit& u) const { const long L = (long)i * G + c; if (L >= (long)nM * nN) return false; u.pm = mb0 + (int)(L % nM); u.pn = (int)(L / nM); return true; }
    __device__ __forceinline__ void a_ready(const Unit&) const {}
    __device__ __forceinline__ void done(const Unit&) const {}
    __device__ __forceinline__ const char* bptr(const Gemm& g, const Unit& u, size_t tstep) const { const int slot = u.pm << 8; int e = 0;
#pragma unroll
        for (int i = 1; i < 8; ++i) e += slot >= ps[i] ? 1 : 0;
        return (const char*)g.Bt + (size_t)e * estride + (size_t)u.pn * tstep; }
};
}

__device__ __forceinline__ void moe_pads(const unsigned char* ws, int (&ps)[9]) {
    const int* cnt = (const int*)(ws + WS_CTL + CTL_CNT); int acc = 0;
#pragma unroll
    for (int e = 0; e < 8; ++e) { ps[e] = acc; const int c = __builtin_amdgcn_readfirstlane(__hip_atomic_load(cnt + e, __ATOMIC_RELAXED, __HIP_MEMORY_SCOPE_AGENT)); acc += (c + 255) / 256 * 256; }
    ps[8] = acc;
}
__device__ __forceinline__ void phase_moe_assign(const Args& a, int gw, int lane) {
    unsigned char* ws = a.ws;
    int ps[9]; moe_pads(ws, ps);
    const int* tok_e = (const int*)(ws + WS_TOK); const float* tok_w = (const float*)(ws + WS_TOK + 262144); int* tok_slot = (int*)(ws + WS_TOK + 524288);
    int* slot_tok = (int*)(ws + WS_SLOT); float* slot_w = (float*)(ws + WS_SLOT + 270336);
    const bf16* hb = (const bf16*)(ws + WS_HBUF); bf16* xb = (bf16*)(ws + WS_XB);
    const int row = gw * 16 + (lane & 15), k = (lane >> 4) & 1; const bool act = lane < 32;
    const int e = act ? tok_e[2 * row + k] : -1; int slot = 0;
    int sb[8];
#pragma unroll
    for (int ee = 0; ee < 8; ++ee) sb[ee] = 0;
    { typedef int i32x4 __attribute__((ext_vector_type(4))); const i32x4* wc4 = (const i32x4*)(ws + WS_CTL + 262144);
#pragma unroll 4
        for (int w = lane; w < gw; w += 64) { const i32x4 c0 = wc4[2 * w], c1 = wc4[2 * w + 1];
            sb[0] += c0.x; sb[1] += c0.y; sb[2] += c0.z; sb[3] += c0.w; sb[4] += c1.x; sb[5] += c1.y; sb[6] += c1.z; sb[7] += c1.w; } }
#pragma unroll
    for (int ee = 0; ee < 8; ++ee) {
        const unsigned long long mask = __ballot(e == ee);
        int t = sb[ee];
#pragma unroll
        for (int o = 1; o < 64; o <<= 1) t += __shfl_xor(t, o);
        if (e == ee) slot = ps[ee] + t + __popcll(mask & ((1ull << lane) - 1ull));
    }
    if (act) { slot_tok[slot] = row; slot_w[slot] = tok_w[2 * row + k]; tok_slot[2 * row + k] = slot; }
#pragma unroll 4
    for (int i = 0; i < 32; ++i) { const int r = __shfl(row, i), s = __shfl(slot, i);
        const u32x4* src = (const u32x4*)(hb + (size_t)r * 1024); u32x4* dst = (u32x4*)(xb + (size_t)s * 1024);
        dst[lane] = src[lane]; dst[lane + 64] = src[lane + 64]; }
}
struct TrDesc { const float* src; bf16* dst; int ldn, ldk; };
__device__ __forceinline__ TrDesc moe_tr_desc(const Args& a, int it) {
    constexpr int I_W1 = 16 * 56, I_W2 = 56 * 16, PER_E = 2 * I_W1 + I_W2; unsigned char* ws = a.ws;
    const int e = it / PER_E; int r = it % PER_E; TrDesc d;
    if (r < 2 * I_W1) { const int which = r / I_W1, q = r % I_W1, kb = q / 56, nb = q % 56;
        d.src = a.in[which ? 23 : 22] + (size_t)e * 1024 * DFFE + (size_t)(64 * kb) * DFFE + 64 * nb; d.ldn = DFFE;
        d.dst = (bf16*)(ws + WS_MW13) + ((size_t)e * 7168 + w13_row(64 * nb) + 128 * which) * 1024 + 64 * kb; d.ldk = 1024; }
    else { r -= 2 * I_W1; const int kb = r / 16, nb = r % 16;
        d.src = a.in[24] + (size_t)e * DFFE * 1024 + (size_t)(64 * kb) * 1024 + 64 * nb; d.ldn = 1024;
        d.dst = (bf16*)(ws + WS_MW2) + ((size_t)e * 1024 + 64 * nb) * DFFE + 64 * kb; d.ldk = DFFE; }
    return d;
}
__device__ __forceinline__ void phase_moe_convert(const Args& a, LAS unsigned char* lds, int gw, int ngw, int wave, int lane) {
    LAS float* scr = (LAS float*)(lds + wave * 16640);
    constexpr int NIT = 8 * (2 * 16 * 56 + 56 * 16);
    const int r = lane >> 4, c4 = lane & 15, c = lane & 7;
    if (gw >= NIT) return;
    TrDesc cur = moe_tr_desc(a, gw);
    f32x4 v[16];
#pragma unroll
    for (int i = 0; i < 16; ++i) v[i] = __builtin_nontemporal_load((const f32x4*)(cur.src + (size_t)(4 * i + r) * cur.ldn + 4 * c4));
#pragma unroll 1
    for (int it = gw; it < NIT; it += ngw) {
        const bool more = it + ngw < NIT; TrDesc nxt = more ? moe_tr_desc(a, it + ngw) : cur;
        f32x4 nv[16];
#pragma unroll
        for (int i = 0; i < 16; ++i) nv[i] = __builtin_nontemporal_load((const f32x4*)(nxt.src + (size_t)(4 * i + r) * nxt.ldn + 4 * c4));
#pragma unroll
        for (int i = 0; i < 16; ++i) { LAS float* d = scr + (4 * i + r) * 65 + 4 * c4; d[0] = v[i][0]; d[1] = v[i][1]; d[2] = v[i][2]; d[3] = v[i][3]; }
        LDS_WAIT();
#pragma unroll
        for (int j = 0; j < 8; ++j) { const int n = (lane >> 3) + 8 * j; const LAS float* s = scr + (8 * c) * 65 + n;
            u32x4 o; o.x = pk2(s[0 * 65], s[1 * 65]); o.y = pk2(s[2 * 65], s[3 * 65]); o.z = pk2(s[4 * 65], s[5 * 65]); o.w = pk2(s[6 * 65], s[7 * 65]);
            *(u32x4*)(cur.dst + (size_t)n * cur.ldk + 8 * c) = o; }
        LDS_WAIT();
#pragma unroll
        for (int i = 0; i < 16; ++i) v[i] = nv[i];
        cur = nxt;
    }
}
__device__ __forceinline__ void phase_moe_combine(const Args& a, int gw, int ngw, int lane) {
    unsigned char* ws = a.ws;
    const float* tok_w = (const float*)(ws + WS_TOK + 262144); const int* tok_slot = (const int*)(ws + WS_TOK + 524288);
    const bf16* y = (const bf16*)(ws + WS_XB);
    const float* gate = (const float*)(ws + WS_CTL + CTL_MODV) + (size_t)3 * 6144 + 5120;
    auto ld_idx = [&](int row, int& s0, int& s1, float& w0, float& w1) { const int r = row < NLAT ? row : gw; s0 = tok_slot[2 * r]; s1 = tok_slot[2 * r + 1]; w0 = tok_w[2 * r]; w1 = tok_w[2 * r + 1]; };
    int s0c, s1c, s0n, s1n; float w0c, w1c, w0n, w1n;
    ld_idx(gw, s0c, s1c, w0c, w1c); ld_idx(gw + ngw, s0n, s1n, w0n, w1n);
    f32x4 xc[4]; u32x2 yac[4], ybc[4];
    { const float* xr0 = a.out + (size_t)gw * 1024;
#pragma unroll
        for (int j = 0; j < 4; ++j) { const int k = 4 * lane + 256 * j; xc[j] = *(const f32x4*)(xr0 + k); yac[j] = *(const u32x2*)(y + (size_t)s0c * 1024 + k); ybc[j] = *(const u32x2*)(y + (size_t)s1c * 1024 + k); } }
    for (int row = gw; row < NLAT; row += ngw) {
        int s0f, s1f; float w0f, w1f; ld_idx(row + 2 * ngw, s0f, s1f, w0f, w1f);
        f32x4 xn[4]; u32x2 yan[4], ybn[4];
        { const int rn = row + ngw < NLAT ? row + ngw : row; const float* xr2 = a.out + (size_t)rn * 1024;
#pragma unroll
            for (int j = 0; j < 4; ++j) { const int k = 4 * lane + 256 * j; xn[j] = *(const f32x4*)(xr2 + k); yan[j] = *(const u32x2*)(y + (size_t)s0n * 1024 + k); ybn[j] = *(const u32x2*)(y + (size_t)s1n * 1024 + k); } }
        float* xr = a.out + (size_t)row * 1024; const float* g = gate + (row >> 14) * 6144; const float w0 = w0c, w1 = w1c;
#pragma unroll
        for (int j = 0; j < 4; ++j) { const int k = 4 * lane + 256 * j; const u32x2 ya = yac[j], yb = ybc[j];
            f32x4 m; m[0] = w0 * bflo(ya.x) + w1 * bflo(yb.x); m[1] = w0 * bfhi(ya.x) + w1 * bfhi(yb.x); m[2] = w0 * bflo(ya.y) + w1 * bflo(yb.y); m[3] = w0 * bfhi(ya.y) + w1 * bfhi(yb.y);
            *(f32x4*)(xr + k) = xc[j] + *(const f32x4*)(g + k) * m; }
#pragma unroll
        for (int j = 0; j < 4; ++j) { xc[j] = xn[j]; yac[j] = yan[j]; ybc[j] = ybn[j]; }
        s0c = s0n; s1c = s1n; w0c = w0n; w1c = w1n; s0n = s0f; s1n = s1f; w0n = w0f; w1n = w1f;
    }
}
constexpr int PQ = 0, PK = 17408, PV = 34816, PKK = 52224, PAS = 85504, PTS = 118272, PGC = 136704;
__device__ __forceinline__ void dn_prep_item(const Args& a, int l, int item, LAS unsigned char* lds, int tid, int wave, int lane) {
    unsigned char* ws = a.ws;
    const int h = item & 3, cs = (item >> 2) % 260, b = (item >> 2) / 260;
    const int rowbase = cs < 4 ? NLAT + b * CTXL + 64 * cs : b * SEQ + 64 * (cs - 4);
    const int seqlo = cs < 4 ? NLAT + b * CTXL : b * SEQ, seqhi = cs < 4 ? seqlo + CTXL : seqlo + SEQ;
    const bf16* qkv = (const bf16*)(ws + WS_QKV);
    unsigned char* dns = ws + WS_DNS + (size_t)item * DNS_ITEM;
    float gpre = 0.f, bpre = 0.f;
    if (wave < 2) { const int tok = wave ? 63 - lane : lane; const float* gb = (const float*)(ws + WS_GAB) + (size_t)(rowbase + tok) * 16; gpre = gb[wave * 4 + h]; bpre = gb[8 + wave * 4 + h]; }
    { LAS float* cwl = (LAS float*)(lds + PAS);
        for (int i = tid; i < 1152; i += 512) { const int sj = i >> 7, c = i & 127, sec = sj / 3, j = sj % 3; cwl[i] = a.in[9][(size_t)l * 3 * 1536 + j * 1536 + sec * 512 + h * 128 + c]; } }
    __syncthreads();
    {
        const int r = tid >> 3, cgp = tid & 7, row = rowbase + r;
        float vals[3][16];
#pragma unroll
        for (int sec = 0; sec < 3; ++sec) {
            const int ch = sec * 512 + h * 128 + cgp * 16;
            const LAS float* cw = (const LAS float*)(lds + PAS) + sec * 384 + cgp * 16;
            float acc[16];
#pragma unroll
            for (int e = 0; e < 16; ++e) acc[e] = 0.f;
            u32x4 P[3][2]; float msk[3];
#pragma unroll
            for (int j = 0; j < 3; ++j) { const int rr = row + j - 1; msk[j] = (rr >= seqlo && rr < seqhi) ? 1.0f : 0.0f; const int rc = min(max(rr, seqlo), seqhi - 1);
                P[j][0] = *(const u32x4*)(qkv + (size_t)rc * 1536 + ch); P[j][1] = *(const u32x4*)(qkv + (size_t)rc * 1536 + ch + 8); }
#pragma unroll
            for (int j = 0; j < 3; ++j) { const u32x4 p0 = P[j][0], p1 = P[j][1]; const float m = msk[j];
                    const unsigned pw[8] = {p0.x, p0.y, p0.z, p0.w, p1.x, p1.y, p1.z, p1.w};
#pragma unroll
                    for (int e = 0; e < 8; ++e) { acc[2 * e] += bflo(pw[e]) * (cw[j * 128 + 2 * e] * m); acc[2 * e + 1] += bfhi(pw[e]) * (cw[j * 128 + 2 * e + 1] * m); } }
#pragma unroll
            for (int e = 0; e < 16; ++e) vals[sec][e] = silu_f(acc[e]);
            __builtin_amdgcn_sched_barrier(0);
        }
#pragma unroll
        for (int sec = 0; sec < 3; ++sec) {
            float sc = 1.0f;
            if (sec < 2) { float ss = 0.f;
#pragma unroll
                for (int e = 0; e < 16; ++e) ss += vals[sec][e] * vals[sec][e];
                ss += __shfl_xor(ss, 1); ss += __shfl_xor(ss, 2); ss += __shfl_xor(ss, 4);
                sc = rsqrtf(ss + EPS); }
            LAS unsigned* dst = (LAS unsigned*)(lds + (sec == 0 ? PQ : sec == 1 ? PK : PV) + r * 272 + cgp * 32);
#pragma unroll
            for (int e = 0; e < 8; ++e) dst[e] = pk2(vals[sec][2 * e] * sc, vals[sec][2 * e + 1] * sc);
        }
    }
    __syncthreads();
    {
#pragma unroll
        for (int i = 0; i < 2; ++i) { const int p = tid + 512 * i, mt = p >> 8, kk = (p >> 6) & 3, ln = p & 63, row = 16 * mt + (ln & 15), g = ln >> 4;
            const LAS unsigned char* src = lds + PQ + row * 272 + (32 * kk + 4 * g) * 2;
            const u32x2 lo = *(const LAS u32x2*)src, hi = *(const LAS u32x2*)(src + 32);
            *(u32x4*)(dns + (size_t)p * 16) = (u32x4){lo.x, lo.y, hi.x, hi.y}; }
        for (int p = tid; p < 1088; p += 512) *(u32x4*)(dns + 16384 + (size_t)p * 16) = *(const LAS u32x4*)(lds + PK + p * 16);
#pragma unroll
        for (int i = 0; i < 4; ++i) { const int p = tid + 512 * i, s = p >> 8, mt = (p >> 6) & 3, ln = p & 63, tok = 16 * mt + 4 * (ln >> 4), dv = 16 * s + (ln & 15);
            const LAS bf16* vs = (const LAS bf16*)(lds + PV);
            *(u32x2*)(dns + 33792 + (size_t)p * 8) = (u32x2){(unsigned)vs[tok * 136 + dv] | ((unsigned)vs[(tok + 1) * 136 + dv] << 16), (unsigned)vs[(tok + 2) * 136 + dv] | ((unsigned)vs[(tok + 3) * 136 + dv] << 16)}; }
    }
    {
#pragma unroll
        for (int t = 0; t < 4; ++t) { const int T = 4 * wave + t, which = T >> 4, ti = (T >> 2) & 3, tj = T & 3; f32x4 acc = {0.f, 0.f, 0.f, 0.f};
#pragma unroll
            for (int kk = 0; kk < 4; ++kk) { const bf16x8 av = *(const LAS bf16x8*)(lds + (which ? PQ : PK) + (16 * ti + (lane & 15)) * 272 + (32 * kk + 8 * (lane >> 4)) * 2);
                const bf16x8 bv = *(const LAS bf16x8*)(lds + PK + (16 * tj + (lane & 15)) * 272 + (32 * kk + 8 * (lane >> 4)) * 2);
                acc = MFMA16(av, bv, acc); }
            LAS float* o = (LAS float*)(lds + PKK) + which * 4160 + (16 * ti + 4 * (lane >> 4)) * 65 + 16 * tj + (lane & 15);
#pragma unroll
            for (int r = 0; r < 4; ++r) o[r * 65] = acc[r]; }
    }
    if (wave < 2) { const int d = wave, tok = d ? 63 - lane : lane;
        float gc = gpre; const float bt = bpre;
#pragma unroll
        for (int o = 1; o < 64; o <<= 1) { const float t = __shfl_up(gc, o); if (lane >= o) gc += t; }
        const float glast = __shfl(gc, 63);
        LAS float* gcs = (LAS float*)(lds + PGC) + d * 128; gcs[tok] = gc; gcs[64 + tok] = bt;
        float* aux = (float*)(ws + WS_DND + (size_t)(item * 2 + d) * DND_ITEM + 16384);
        aux[tok] = bt; aux[64 + tok] = __expf(gc); aux[128 + tok] = __expf(glast - gc); if (lane == 0) aux[192] = __expf(glast); }
    __syncthreads();
    {
        const LAS float* kkm = (const LAS float*)(lds + PKK); const LAS float* qkm = kkm + 4160;
#pragma unroll
        for (int d = 0; d < 2; ++d) { const LAS float* gcs = (const LAS float*)(lds + PGC) + d * 128; LAS float* as = (LAS float*)(lds + PAS) + d * 4096;
            for (int idx = tid; idx < 4096; idx += 512) { const int p = idx >> 6, p2 = idx & 63, i = d ? 63 - p : p, j = d ? 63 - p2 : p2;
                as[idx] = p2 < p ? gcs[64 + i] * kkm[i * 65 + j] * __expf(gcs[i] - gcs[j]) : 0.f; }
            { const int mt = tid >> 7, kk = (tid >> 6) & 1, ln = tid & 63, i = 16 * mt + (ln & 15), g = ln >> 4; float v[8];
#pragma unroll
                for (int e = 0; e < 8; ++e) { const int j = 32 * kk + (e < 4 ? 4 * g + e : 16 + 4 * g + e - 4); const bool ok = d ? (j >= i) : (j <= i);
                    v[e] = ok ? qkm[i * 65 + j] * __expf(gcs[i] - gcs[j]) * 0.08838834764831845f : 0.f; }
                *(u32x4*)(ws + WS_DND + (size_t)(item * 2 + d) * DND_ITEM + 8192 + (size_t)tid * 16) = (u32x4){pk2(v[0], v[1]), pk2(v[2], v[3]), pk2(v[4], v[5]), pk2(v[6], v[7])}; }
        }
    }
    __syncthreads();
    if (wave < 2) { const int d = wave; const LAS float* as = (const LAS float*)(lds + PAS) + d * 4096; float t[64];
        t[0] = (lane == 0) ? 1.0f : 0.0f;
        int ar = __float_as_int(as[64 + lane]);
#pragma unroll
        for (int p = 1; p < 64; ++p) {
            const int an = __float_as_int(as[((p + 1) & 63) * 64 + lane]);
            float acc = (p == lane) ? 1.0f : 0.0f;
#pragma unroll
            for (int p2 = 0; p2 < p; ++p2) acc -= __int_as_float(__builtin_amdgcn_readlane(ar, p2)) * t[p2];
            t[p] = acc; ar = an; }
        LAS bf16* ts = (LAS bf16*)(lds + PTS) + d * 4608; const int jc = d ? 63 - lane : lane;
#pragma unroll
        for (int p = 0; p < 64; ++p) { const int i = d ? 63 - p : p; ts[i * 72 + jc] = f2bf(t[p]); } }
    __syncthreads();
    {
#pragma unroll
        for (int d = 0; d < 2; ++d) { const int mt = tid >> 7, kk = (tid >> 6) & 1, ln = tid & 63, i = 16 * mt + (ln & 15), g = ln >> 4;
            const LAS unsigned char* src = lds + PTS + d * 9216 + i * 144 + (32 * kk + 4 * g) * 2;
            const u32x2 lo = *(const LAS u32x2*)src, hi = *(const LAS u32x2*)(src + 32);
            *(u32x4*)(ws + WS_DND + (size_t)(item * 2 + d) * DND_ITEM + (size_t)tid * 16) = (u32x4){lo.x, lo.y, hi.x, hi.y}; }
    }
    __syncthreads();
}

__device__ __forceinline__ void na_prep_item(const Args& a, int l, int item8, int lane) {
    unsigned char* ws = a.ws; const int item = item8 >> 3, part = item8 & 7;
    const int row = item * 64 + lane;
    bf16* na = (bf16*)(ws + WS_NA) + (size_t)row * 768; bf16* vt = (bf16*)(ws + WS_VT);
    const int b = row < NLAT ? (row >> 14) : ((row - NLAT) >> 8), tpos = row < NLAT ? (row & 16383) : 16384 + ((row - NLAT) & 255);
    const float* qn = a.in[13] + l * 64; const float* kn = a.in[14] + l * 64;
    { const int sec = part >> 2, h = part & 3;
        { u32x4* p = (u32x4*)(na + sec * 256 + h * 64); u32x4 v[8]; float ss = 0.f;
#pragma unroll
            for (int i = 0; i < 8; ++i) { v[i] = p[i]; const unsigned w[4] = {v[i].x, v[i].y, v[i].z, v[i].w};
#pragma unroll
                for (int e = 0; e < 4; ++e) { const float x = bflo(w[e]), y = bfhi(w[e]); ss += x * x + y * y; } }
            const float sc = rsqrtf(ss * (1.0f / 64.0f) + EPS); const float* nw = sec == 0 ? qn : kn;
#pragma unroll
            for (int i = 0; i < 8; ++i) { const unsigned w[4] = {v[i].x, v[i].y, v[i].z, v[i].w}; unsigned o[4];
#pragma unroll
                for (int e = 0; e < 4; ++e) o[e] = pk2(bflo(w[e]) * sc * nw[8 * i + 2 * e], bfhi(w[e]) * sc * nw[8 * i + 2 * e + 1]);
                p[i] = (u32x4){o[0], o[1], o[2], o[3]}; } } }
    if (part < 4) { const int h = part; const u32x4* p = (const u32x4*)(na + 512 + h * 64); bf16* dst = vt + ((size_t)(b * 4 + h) * 64) * 16640 + tpos;
#pragma unroll
        for (int i = 0; i < 8; ++i) { const u32x4 v = p[i]; const unsigned w[4] = {v.x, v.y, v.z, v.w};
#pragma unroll
            for (int e = 0; e < 4; ++e) { dst[(size_t)(8 * i + 2 * e) * 16640] = (bf16)(w[e] & 0xffffu); dst[(size_t)(8 * i + 2 * e + 1) * 16640] = (bf16)(w[e] >> 16); } } }
}

__device__ __forceinline__ void ft_stage1_item(const Args& a, int item, LAS unsigned char* lds, int tid, int wave, int lane) {
    unsigned char* ws = a.ws; const int b = item >> 7, t0 = item & 127;
    const bf16* ft = (const bf16*)(ws + WS_FT);
#pragma unroll
    for (int i = 0; i < 8; ++i) { const int p = tid + 512 * i, t1 = p >> 5, cp = p & 31;
        *(LAS u32x4*)(lds + t1 * 528 + cp * 16) = *(const u32x4*)(ft + (size_t)(b * SEQ + 128 * t1 + t0) * 256 + cp * 8); }
    __syncthreads();
    const int fr = lane & 15, g = lane >> 4, q = fr >> 2, pp = fr & 3;
    const bf16* f1 = (const bf16*)(ws + WS_F1);
    bf16x8 af[2][4];
#pragma unroll
    for (int c = 0; c < 2; ++c)
#pragma unroll
        for (int kk = 0; kk < 4; ++kk) af[c][kk] = *(const bf16x8*)(f1 + (size_t)(c * 128 + 16 * wave + fr) * 128 + 32 * kk + 8 * g);
    const f32x2* tw = (const f32x2*)(ws + WS_TWID); f32x2 twv[4];
#pragma unroll
    for (int r = 0; r < 4; ++r) twv[r] = tw[((16 * wave + 4 * g + r) * t0) & 16383];
    bf16* yb = (bf16*)(ws + WS_Y);
    const unsigned lbase = (unsigned)(size_t)(lds) + (8 * g + q) * 528 + 8 * pp;
#pragma unroll 2
    for (int nt = 0; nt < 16; ++nt) { f32x4 yr = {0.f, 0.f, 0.f, 0.f}, yi = {0.f, 0.f, 0.f, 0.f};
        u32x2 t[8];
#pragma unroll
        for (int kk = 0; kk < 4; ++kk) { const unsigned ad = lbase + 32 * kk * 528 + 32 * nt; t[2 * kk] = tr_issue(ad); t[2 * kk + 1] = tr_issue(ad + 4 * 528); }
        tr_wait8(t[0], t[1], t[2], t[3], t[4], t[5], t[6], t[7]);
#pragma unroll
        for (int kk = 0; kk < 4; ++kk) { const bf16x8 bv = mk8(t[2 * kk].x, t[2 * kk].y, t[2 * kk + 1].x, t[2 * kk + 1].y);
            yr = MFMA16(af[0][kk], bv, yr); yi = MFMA16(af[1][kk], bv, yi); }
#pragma unroll
        for (int r = 0; r < 4; ++r) { const int kb = 16 * wave + 4 * g + r; const float cs = twv[r][0], sn = twv[r][1];
            const float pr = yr[r] * cs + yi[r] * sn, pi = yi[r] * cs - yr[r] * sn;
            const size_t o = ((((size_t)b * 128 + kb) * 2) * 128 + t0) * 256 + 16 * nt + fr;
            yb[o] = f2bf(pr); yb[o + 128 * 256] = f2bf(pi); } }
    __syncthreads();
}
constexpr int SC_Q = 0, SC_K = 16384, SC_T = 33792, SC_QK = 41984, SC_AUX = 50176, SC_BUF = 51200, SC_RPB = 0;
__device__ __forceinline__ void scan_issue(const unsigned char* ws, int item, int d, LAS unsigned char* buf, int wave, int lane) {
    const unsigned char* gs = ws + WS_DNS + (size_t)item * DNS_ITEM + lane * 16;
    const unsigned char* gd = ws + WS_DND + (size_t)(item * 2 + d) * DND_ITEM + lane * 16;
#pragma unroll 1
    for (int i = wave - 2; i < 50; i += 6) { const unsigned char* src = i < 33 ? gs + i * 1024 : gd + (i - 33) * 1024;
        __builtin_amdgcn_global_load_lds((const unsigned*)src, (LAS unsigned*)(buf + i * 1024), 16, 0, 0); }
}
__device__ __forceinline__ void scan_block(const Args& a, int chain, int sg, LAS unsigned char* lds, int wave, int lane) {
    const unsigned char* ws = a.ws;
    const int h = chain & 3, d = (chain >> 2) & 1, b = chain >> 3, fr = lane & 15, g = lane >> 4, s = 2 * sg + (wave & 1);
    bf16* obuf = (bf16*)(ws + WS_HBUF) + (size_t)d * NROW * 512;
    f32x4 S[8];
#pragma unroll
    for (int i = 0; i < 8; ++i) S[i] = (f32x4){0.f, 0.f, 0.f, 0.f};
    auto item_of = [&](int step) { const int cs = step < 4 ? (d ? 3 - step : step) : 4 + (d ? 259 - step : step - 4); return ((b * 260 + cs) << 2) + h; };
    auto load_v = [&](int step, u32x2 (&vv)[4]) { const unsigned char* gv = ws + WS_DNS + (size_t)item_of(step) * DNS_ITEM + 33792 + s * 2048 + lane * 8;
#pragma unroll
        for (int mt = 0; mt < 4; ++mt) vv[mt] = *(const u32x2*)(gv + mt * 512); };
    u32x2 vcur[4], vnxt[4];
#pragma unroll
    for (int mt = 0; mt < 4; ++mt) { vcur[mt] = (u32x2){0u, 0u}; vnxt[mt] = (u32x2){0u, 0u}; }
    if (wave >= 2) { scan_issue(ws, item_of(0), d, lds, wave, lane); scan_issue(ws, item_of(1), d, lds + SC_BUF, wave, lane); }
    if (wave < 2) load_v(0, vcur);
    VM_WAIT(); __builtin_amdgcn_s_barrier(); asm volatile("" ::: "memory");
    int bsel = 0;
#pragma unroll 1
    for (int step = 0; step < 260; ++step) {
        const int b2 = bsel >= 1 ? bsel - 1 : 2;
        if (wave >= 2 && step + 2 < 260) scan_issue(ws, item_of(step + 2), d, lds + b2 * SC_BUF, wave, lane);
        if (wave < 2) {
        if (step + 1 < 260) load_v(step + 1, vnxt);
        LAS unsigned char* bf = lds + bsel * SC_BUF;
        const unsigned ktbase = (unsigned)(size_t)bf + SC_K + (4 * g + (fr >> 2)) * 272 + 8 * (fr & 3);
        const int cs = step < 4 ? (d ? 3 - step : step) : 4 + (d ? 259 - step : step - 4);
        const int rowbase = cs < 4 ? NLAT + b * CTXL + 64 * cs : b * SEQ + 64 * (cs - 4);
        bf16x8 Sb[4];
#pragma unroll
        for (int kk = 0; kk < 4; ++kk) Sb[kk] = pack8(S[2 * kk], S[2 * kk + 1]);
        bf16x8 KF[4][4], QF[4][4];
#pragma unroll
        for (int mt = 0; mt < 4; ++mt)
#pragma unroll
            for (int kk = 0; kk < 4; ++kk) { const LAS unsigned char* kp = bf + SC_K + (16 * mt + fr) * 272 + (32 * kk + 4 * g) * 2; const u32x2 klo = *(const LAS u32x2*)kp, khi = *(const LAS u32x2*)(kp + 32);
                KF[mt][kk] = mk8(klo.x, klo.y, khi.x, khi.y); QF[mt][kk] = *(const LAS bf16x8*)(bf + SC_Q + ((mt * 4 + kk) * 64 + lane) * 16); }
        LDS_WAIT();
        f32x4 KS[4], QS[4];
#pragma unroll
        for (int mt = 0; mt < 4; ++mt) { KS[mt] = (f32x4){0.f, 0.f, 0.f, 0.f}; QS[mt] = (f32x4){0.f, 0.f, 0.f, 0.f};
#pragma unroll
            for (int kk = 0; kk < 4; ++kk) { KS[mt] = MFMA16(KF[mt][kk], Sb[kk], KS[mt]); QS[mt] = MFMA16(QF[mt][kk], Sb[kk], QS[mt]); } }
        bf16x8 TF[4][2], GF[4][2]; f32x4 egc[4], ekd[4], bt4[4];
#pragma unroll
        for (int mt = 0; mt < 4; ++mt) { const int to = (16 * mt + 4 * g) * 4;
            bt4[mt] = *(const LAS f32x4*)(bf + SC_AUX + to); egc[mt] = *(const LAS f32x4*)(bf + SC_AUX + 256 + to); ekd[mt] = *(const LAS f32x4*)(bf + SC_AUX + 512 + to);
#pragma unroll
            for (int k2 = 0; k2 < 2; ++k2) { TF[mt][k2] = *(const LAS bf16x8*)(bf + SC_T + ((mt * 2 + k2) * 64 + lane) * 16); GF[mt][k2] = *(const LAS bf16x8*)(bf + SC_QK + ((mt * 2 + k2) * 64 + lane) * 16); } }
        const float egl = *(const LAS float*)(bf + SC_AUX + 768);
        LDS_WAIT();
        f32x4 D[4];
#pragma unroll
        for (int mt = 0; mt < 4; ++mt) { const u32x2 vv = vcur[mt]; const f32x4 v4 = {bflo(vv.x), bfhi(vv.x), bflo(vv.y), bfhi(vv.y)}; D[mt] = bt4[mt] * (v4 - egc[mt] * KS[mt]); }
        bf16x8 Db[2];
#pragma unroll
        for (int k2 = 0; k2 < 2; ++k2) Db[k2] = pack8(D[2 * k2], D[2 * k2 + 1]);
        f32x4 VN[4];
#pragma unroll
        for (int mt = 0; mt < 4; ++mt) { VN[mt] = (f32x4){0.f, 0.f, 0.f, 0.f};
#pragma unroll
            for (int k2 = 0; k2 < 2; ++k2) VN[mt] = MFMA16(TF[mt][k2], Db[k2], VN[mt]); }
        bf16x8 Vb[2], Vd[2];
#pragma unroll
        for (int k2 = 0; k2 < 2; ++k2) { Vb[k2] = pack8(VN[2 * k2], VN[2 * k2 + 1]); Vd[k2] = pack8(ekd[2 * k2] * VN[2 * k2], ekd[2 * k2 + 1] * VN[2 * k2 + 1]); }
        u32x2 t[32];
#pragma unroll
        for (int dt = 0; dt < 8; ++dt)
#pragma unroll
            for (int k2 = 0; k2 < 2; ++k2) { const unsigned ad = ktbase + (32 * k2) * 272 + (16 * dt) * 2; t[(dt * 2 + k2) * 2] = tr_issue(ad); t[(dt * 2 + k2) * 2 + 1] = tr_issue(ad + 16 * 272); }
#pragma unroll
        for (int mt = 0; mt < 4; ++mt) { f32x4 O = egc[mt] * QS[mt] * 0.08838834764831845f;
#pragma unroll
            for (int k2 = 0; k2 < 2; ++k2) O = MFMA16(GF[mt][k2], Vb[k2], O);
            bf16* op = obuf + (size_t)(rowbase + 16 * mt + 4 * g) * 512 + h * 128 + 16 * s + fr;
#pragma unroll
            for (int r = 0; r < 4; ++r) op[r * 512] = f2bf(O[r]); }
        tr_wait8(t[0], t[1], t[2], t[3], t[4], t[5], t[6], t[7]); tr_wait8(t[8], t[9], t[10], t[11], t[12], t[13], t[14], t[15]);
        tr_wait8(t[16], t[17], t[18], t[19], t[20], t[21], t[22], t[23]); tr_wait8(t[24], t[25], t[26], t[27], t[28], t[29], t[30], t[31]);
#pragma unroll
        for (int dt = 0; dt < 8; ++dt) { f32x4 acc = S[dt] * egl;
#pragma unroll
            for (int k2 = 0; k2 < 2; ++k2) acc = MFMA16(mk8(t[(dt * 2 + k2) * 2].x, t[(dt * 2 + k2) * 2].y, t[(dt * 2 + k2) * 2 + 1].x, t[(dt * 2 + k2) * 2 + 1].y), Vd[k2], acc);
            S[dt] = acc; }
#pragma unroll
        for (int mt = 0; mt < 4; ++mt) vcur[mt] = vnxt[mt];
        }
        if (wave >= 2) { if (step + 2 < 260) { if (wave < 4) asm volatile("s_waitcnt vmcnt(9)" ::: "memory"); else asm volatile("s_waitcnt vmcnt(8)" ::: "memory"); } else VM_WAIT(); }
        LDS_WAIT(); __builtin_amdgcn_s_barrier(); asm volatile("" ::: "memory");
        bsel = bsel == 2 ? 0 : bsel + 1;
    }
}

template <bool CTXQ> __device__ __forceinline__ void na_wave(const Args& a, int item, LAS unsigned char* lds, int lane) {
    const unsigned char* ws = a.ws; const int fr = lane & 15, g = lane >> 4;
    const bf16* na = (const bf16*)(ws + WS_NA); const bf16* vt = (const bf16*)(ws + WS_VT); bf16* mix = (bf16*)(ws + WS_QKV);
    int b, h, r = 0, wq = 0, qrow, r0 = 0, cw0 = 0;
    if (CTXQ) { const int qb = item & 15; h = (item >> 4) & 3; b = item >> 6; qrow = NLAT + b * CTXL + 16 * qb + fr; }
    else { wq = item & 3; r = (item >> 2) & 255; h = (item >> 10) & 3; b = item >> 12; qrow = b * SEQ + 64 * r + 16 * wq + fr;
        r0 = min(max(r - 4, 0), 248); cw0 = min(max(16 * wq - 8, 0), 32); }
    bf16x8 qf[2];
#pragma unroll
    for (int kk = 0; kk < 2; ++kk) qf[kk] = *(const bf16x8*)(na + (size_t)qrow * 768 + h * 64 + 32 * kk + 8 * g);
    constexpr int NT = CTXQ ? 16 : 32, T0 = CTXQ ? 16 : 0;
    f32x4 sc[NT];
#pragma unroll
    for (int t = 0; t < NT; ++t) { const int T = T0 + t;
        const int krow = T < 16 ? b * SEQ + (r0 + (T >> 1)) * 64 + cw0 + 16 * (T & 1) + fr : NLAT + b * CTXL + 16 * (T - 16) + fr;
        f32x4 acc = {0.f, 0.f, 0.f, 0.f};
#pragma unroll
        for (int kk = 0; kk < 2; ++kk) acc = MFMA16(*(const bf16x8*)(na + (size_t)krow * 768 + 256 + h * 64 + 32 * kk + 8 * g), qf[kk], acc);
        sc[t] = acc * (0.125f * LOG2E); if ((t & 3) == 3) __builtin_amdgcn_sched_barrier(0); }
    float mx = -3.0e38f;
    if (!CTXQ) { const LAS float* rpb = (const LAS float*)(lds + SC_RPB) + h * 465; const int qcol = 16 * wq + fr, c0 = min(max(qcol - 8, 0), 48);
#pragma unroll
        for (int t = 0; t < 16; ++t) { const int offr = r0 + (t >> 1) - r + 7;
#pragma unroll
            for (int j = 0; j < 4; ++j) { const int kc = cw0 + 16 * (t & 1) + 4 * g + j; const bool ok = kc >= c0 && kc < c0 + 16; const int offc = min(max(kc - qcol + 15, 0), 30);
                sc[t][j] = ok ? sc[t][j] + rpb[offr * 31 + offc] : -3.0e38f; } } }
#pragma unroll
    for (int t = 0; t < NT; ++t) mx = fmaxf(fmaxf(fmaxf(sc[t][0], sc[t][1]), fmaxf(sc[t][2], sc[t][3])), mx);
    mx = fmaxf(mx, __shfl_xor(mx, 16)); mx = fmaxf(mx, __shfl_xor(mx, 32));
    float sum = 0.f;
#pragma unroll
    for (int t = 0; t < NT; ++t)
#pragma unroll
        for (int j = 0; j < 4; ++j) { const float p = exp2f(sc[t][j] - mx); sc[t][j] = p; sum += p; }
    sum += __shfl_xor(sum, 16); sum += __shfl_xor(sum, 32);
    const float inv = 1.0f / sum;
    f32x4 O[4];
#pragma unroll
    for (int mt = 0; mt < 4; ++mt) O[mt] = (f32x4){0.f, 0.f, 0.f, 0.f};
    const bf16* vbase = vt + ((size_t)(b * 4 + h) * 64 + fr) * 16640;
#pragma unroll
    for (int k2 = 0; k2 < NT / 2; ++k2) { const int T = T0 + 2 * k2;
        const int tp = T < 16 ? (r0 + (T >> 1)) * 64 + cw0 + 4 * g : 16384 + 16 * (T - 16) + 4 * g;
        const bf16x8 pb = pack8(sc[2 * k2] * inv, sc[2 * k2 + 1] * inv);
#pragma unroll
        for (int mt = 0; mt < 4; ++mt) { const bf16* vp = vbase + (size_t)(16 * mt) * 16640 + tp; const u32x2 lo = *(const u32x2*)vp, hi = *(const u32x2*)(vp + 16);
            O[mt] = MFMA16(mk8(lo.x, lo.y, hi.x, hi.y), pb, O[mt]); } if ((k2 & 1) == 1) __builtin_amdgcn_sched_barrier(0); }
#pragma unroll
    for (int mt = 0; mt < 4; ++mt) { const f32x4 o = O[mt];
        *(u32x2*)(mix + (size_t)qrow * 1024 + 512 + h * 64 + 16 * mt + 4 * g) = (u32x2){pk2(o[0], o[1]), pk2(o[2], o[3])}; }
}
__device__ __forceinline__ void dn_combine(const Args& a, int l, int gw, int ngw, int lane) {
    unsigned char* ws = a.ws; const int nrow = l == 0 ? NROW : NLAT;
    const bf16* of = (const bf16*)(ws + WS_HBUF); const bf16* ob = of + (size_t)NROW * 512; const bf16* zb = (const bf16*)(ws + WS_Z); bf16* mix = (bf16*)(ws + WS_QKV);
    const float* nw = a.in[12] + l * 128 + (8 * lane & 127);
    float w[8];
#pragma unroll
    for (int e = 0; e < 8; ++e) w[e] = nw[e];
    for (int row = gw; row < nrow; row += ngw) {
        const u32x4 pf = *(const u32x4*)(of + (size_t)row * 512 + 8 * lane), pb = *(const u32x4*)(ob + (size_t)row * 512 + 8 * lane), pz = *(const u32x4*)(zb + (size_t)row * 512 + 8 * lane);
        const unsigned f[4] = {pf.x, pf.y, pf.z, pf.w}, bb[4] = {pb.x, pb.y, pb.z, pb.w}, zz[4] = {pz.x, pz.y, pz.z, pz.w};
        float o[8], ss = 0.f;
#pragma unroll
        for (int e = 0; e < 4; ++e) { o[2 * e] = bflo(f[e]) + bflo(bb[e]); o[2 * e + 1] = bfhi(f[e]) + bfhi(bb[e]); ss += o[2 * e] * o[2 * e] + o[2 * e + 1] * o[2 * e + 1]; }
        ss += __shfl_xor(ss, 1); ss += __shfl_xor(ss, 2); ss += __shfl_xor(ss, 4); ss += __shfl_xor(ss, 8);
        const float rinv = rsqrtf(ss * (1.0f / 128.0f) + EPS);
        unsigned ow[4];
#pragma unroll
        for (int e = 0; e < 4; ++e) ow[e] = pk2(o[2 * e] * rinv * w[2 * e] * silu_f(bflo(zz[e])), o[2 * e + 1] * rinv * w[2 * e + 1] * silu_f(bfhi(zz[e])));
        *(u32x4*)(mix + (size_t)row * 1024 + 8 * lane) = (u32x4){ow[0], ow[1], ow[2], ow[3]};
    }
}
__device__ __forceinline__ void ft_stage2_item(const Args& a, int l, int item, LAS unsigned char* lds, int tid, int wave, int lane) {
    unsigned char* ws = a.ws; const bool isctx = item >= 256; int b, kb;
    const bf16* src; const bf16* amat; float scale; size_t tokbase; int tokstride;
    if (!isctx) { b = item >> 7; kb = item & 127; src = (const bf16*)(ws + WS_Y) + (size_t)(b * 128 + kb) * 65536; amat = (const bf16*)(ws + WS_A2); scale = 1.0f; tokbase = (size_t)b * SEQ + kb; tokstride = 128; }
    else { b = (item - 256) >> 1; kb = (item - 256) & 1; src = (const bf16*)(ws + WS_FT) + (size_t)(NLAT + b * CTXL) * 256; amat = (const bf16*)(ws + WS_A2C) + (size_t)kb * 65536; scale = 8.0f; tokbase = (size_t)NLAT + b * CTXL + 128 * kb; tokstride = 1; }
#pragma unroll
    for (int i = 0; i < 16; ++i) { const int p = tid + 512 * i, row = p >> 5, cp = p & 31; *(LAS u32x4*)(lds + row * 528 + cp * 16) = *(const u32x4*)(src + (size_t)row * 256 + cp * 8); }
    __syncthreads();
    const int fr = lane & 15, g = lane >> 4, q = fr >> 2, pp = fr & 3;
    const unsigned lbase = (unsigned)(size_t)(lds) + (8 * g + q) * 528 + 8 * pp;
    f32x4 Z[16][2];
#pragma unroll
    for (int mt = 0; mt < 16; ++mt) { Z[mt][0] = (f32x4){0.f, 0.f, 0.f, 0.f}; Z[mt][1] = (f32x4){0.f, 0.f, 0.f, 0.f}; }
#pragma unroll 1
    for (int kk = 0; kk < 8; ++kk) {
        const bf16x8 b0 = *(const bf16x8*)(amat + (size_t)(16 * wave + fr) * 256 + 32 * kk + 8 * g), b1 = *(const bf16x8*)(amat + (size_t)(128 + 16 * wave + fr) * 256 + 32 * kk + 8 * g);
#pragma unroll
        for (int mt = 0; mt < 16; ++mt) { const unsigned ad = lbase + 32 * kk * 528 + 32 * mt; const bf16x8 av = lds_tr8(ad, ad + 4 * 528);
            Z[mt][0] = MFMA16(av, b0, Z[mt][0]); Z[mt][1] = MFMA16(av, b1, Z[mt][1]); }
    }
    bf16x8 Zb[16];
#pragma unroll
    for (int k3 = 0; k3 < 16; ++k3) { const int c = k3 >> 3, k2 = k3 & 7; Zb[k3] = pack8(Z[2 * k2][c], Z[2 * k2 + 1][c]); }
    const bf16* wft = (const bf16*)(ws + WS_WFT) + (size_t)l * 131072; bf16* mix = (bf16*)(ws + WS_QKV);
    const size_t tok = tokbase + (size_t)(16 * wave + fr) * tokstride;
#pragma unroll 2
    for (int jt = 0; jt < 16; ++jt) { f32x4 acc = {0.f, 0.f, 0.f, 0.f};
#pragma unroll
        for (int k3 = 0; k3 < 16; ++k3) acc = MFMA16(*(const bf16x8*)(wft + ((size_t)(jt * 16 + k3) * 64 + lane) * 8), Zb[k3], acc);
        acc = acc * scale;
        *(u32x2*)(mix + tok * 1024 + 768 + 16 * jt + 4 * g) = (u32x2){pk2(acc[0], acc[1]), pk2(acc[2], acc[3])}; }
    __syncthreads();
}
__global__ __launch_bounds__(512, 2) void mega(Args a0) {
    extern __shared__ __attribute__((aligned(16))) unsigned char shm[];
    cg::grid_group grid = cg::this_grid();
    const int tid0 = threadIdx.x, blk0 = blockIdx.x, nblk = gridDim.x;
#ifndef REP_PH
#define REP_PH (-1)
#endif
    volatile LAS unsigned* xb_st = (volatile LAS unsigned*)((LAS unsigned char*)shm + LDS_BYTES - 16);
    if (tid0 == 0) { xb_st[0] = 0u; xb_st[1] = 0u; }
    __syncthreads();
    const XcdBarrier xb = xcd_barrier_post((unsigned*)(a0.ws + WS_CTL + 524288), xb_st);
    int ph = 0;
#define PH_BEGIN if (ph >= a0.lo && ph < a0.hi) { if (ph > a0.lo) { if (a0.lo < 0) grid.sync(); xcd_barrier(xb); } \
    int tid = tid0, blk = blk0; asm volatile("" : "+v"(tid)); asm volatile("" : "+s"(blk)); \
    Args a = a0; asm volatile("" : "+s"(a.ws)); asm volatile("" : "+s"(a.out)); \
    LAS unsigned char* lds = (LAS unsigned char*)shm; unsigned char* ws = a.ws; const float* modv = (const float*)(ws + WS_CTL + CTL_MODV); \
    const int wave = __builtin_amdgcn_readfirstlane(tid >> 6), lane = tid & 63; \
    const int gw = blk * 8 + wave, ngw = nblk * 8, gtid = blk * 512 + tid, ngt = nblk * 512; (void)gtid; (void)ngt; (void)gw; (void)ngw; (void)modv; (void)lds; (void)lane;
#define PH_END } ++ph;
#ifndef REPP
#define REPP 1
#endif
    PH_BEGIN { for (int rr = 0; rr < REPP; ++rr) phase_prologue(a, lds, gw, ngw, wave, lane, gtid, ngt); } PH_END
#ifdef XSYNC
    for (int xs = 0; xs < XSYNC; ++xs) { asm volatile("s_waitcnt vmcnt(0) lgkmcnt(0)" ::: "memory"); grid.sync(); __builtin_amdgcn_fence(__ATOMIC_ACQUIRE, "agent"); }
#endif
#pragma unroll 1
    for (int l = 0; l < 2; ++l) {
        PH_BEGIN phase_A(a, l, lds, gw, ngw, tid, lane); PH_END
        PH_BEGIN { pg8::Gemm g{(const pg8::bf16_t*)(ws + WS_HBUF), (const pg8::bf16_t*)(ws + WS_WIN) + (size_t)l * 3072 * 1024, NROW, 3072, 1024};
            pg8::StaticOrder S; S.init(NROW, 3072, nblk, blk); pg8::EpiProj E{ws}; pg8::gemm_phase<pg8::EpiProj, pg8::StaticOrder, false>(lds, g, S, E, nullptr); __syncthreads(); } PH_END
        PH_BEGIN {
            for (int it = gw; it < 4160; it += ngw) na_prep_item(a, l, it, lane);
            { unsigned* qctr = (unsigned*)(ws + WS_CTL + 540672 + 1024) + l * 64; volatile LAS unsigned* qw = (volatile LAS unsigned*)(lds + LDS_BYTES - 32);
                auto grab = [&]() { if (tid == 0) *qw = __hip_atomic_fetch_add(qctr, 1u, __ATOMIC_RELAXED, __HIP_MEMORY_SCOPE_AGENT); __syncthreads(); const int v = (int)*qw; __syncthreads(); return v; };
                int it = grab();
#pragma unroll 1
                while (it < 2080) { dn_prep_item(a, l, it, lds, tid, wave, lane); it = grab(); }
#pragma unroll 1
                while (it < 2080 + 256) { ft_stage1_item(a, it - 2080, lds, tid, wave, lane); it = grab(); } }
        } PH_END
        PH_BEGIN {
            if (blk < 64) scan_block(a, blk & 15, blk >> 4, lds, wave, lane);
            else { LAS float* rpb = (LAS float*)(lds + SC_RPB);
                for (int i = tid; i < 1860; i += 512) rpb[i] = a.in[15][l * 1860 + i] * LOG2E;
                __syncthreads();
                const int nidx = (blk - 64) * 8 + wave;
#pragma unroll 1
                for (int it = nidx; it < 8192 + 128; it += 1536) { if (it < 8192) na_wave<false>(a, it, lds, lane); else if (l == 0) na_wave<true>(a, it - 8192, lds, lane); }
                __syncthreads();
                const int nft = l == 0 ? 260 : 256;
                for (int it = blk - 64; it < nft; it += 192) ft_stage2_item(a, l, it, lds, tid, wave, lane); }
            __syncthreads();
        } PH_END
        PH_BEGIN {
            dn_combine(a, l, gw, ngw, lane);
        } PH_END
        PH_BEGIN { const int M = l == 0 ? NROW : NLAT;
            pg8::Gemm g{(const pg8::bf16_t*)(ws + WS_QKV), (const pg8::bf16_t*)(ws + WS_WOUT) + (size_t)l * 1024 * 1024, M, 1024, 1024};
            pg8::StaticOrder S; S.init(M, 1024, nblk, blk);
            pg8::EpiResid E{l == 0 ? a.in[0] : a.out, l == 0 ? a.in[2] : (const float*)(ws + WS_CTXS), a.out, (float*)(ws + WS_CTXS), modv + (size_t)l * 3 * 6144 + 2048};
            pg8::gemm_phase<pg8::EpiResid, pg8::StaticOrder, false>(lds, g, S, E, nullptr); __syncthreads(); } PH_END
#ifndef REPM
#define REPM 1
#endif
        PH_BEGIN { phase_F(a, l, lds, gw, ngw, tid, lane); if (l == 1) for (int rr = 0; rr < REPM; ++rr) phase_moe_convert(a, lds, gw, ngw, wave, lane); } PH_END
        if (l == 0) {
            PH_BEGIN { pg8::Gemm g{(const pg8::bf16_t*)(ws + WS_HBUF), (const pg8::bf16_t*)(ws + WS_W13), NROW, 5632, 1024};
                pg8::StaticOrder S; S.init(NROW, 5632, nblk, blk); pg8::EpiSwiglu E{(pg8::bf16_t*)(ws + WS_ACT), DFF, 0};
                pg8::gemm_phase<pg8::EpiSwiglu, pg8::StaticOrder, false>(lds, g, S, E, nullptr); __syncthreads(); } PH_END
            PH_BEGIN { pg8::Gemm g{(const pg8::bf16_t*)(ws + WS_ACT), (const pg8::bf16_t*)(ws + WS_W2), NROW, 1024, DFF};
                pg8::StaticOrder S; S.init(NROW, 1024, nblk, blk);
                pg8::EpiResid E{a.out, (const float*)(ws + WS_CTXS), a.out, (float*)(ws + WS_CTXS), modv + 5120};
                pg8::gemm_phase<pg8::EpiResid, pg8::StaticOrder, false>(lds, g, S, E, nullptr); __syncthreads(); } PH_END
        } else {
            PH_BEGIN phase_moe_assign(a, gw, lane); PH_END
            {
                int ps[9]; moe_pads(a0.ws, ps);
                const int nbt = ps[8] >> 8;
#pragma unroll 1
                for (int c0 = 0; c0 < nbt; c0 += MACT_ROWS / 256) {
                    const int nM = nbt - c0 < MACT_ROWS / 256 ? nbt - c0 : MACT_ROWS / 256;
                    PH_BEGIN { pg8::Gemm g{(const pg8::bf16_t*)(ws + WS_XB), (const pg8::bf16_t*)(ws + WS_MW13), 0, 7168, 1024};
                        pg8::MoeOrder S{nM, 28, c0, nblk, blk, {ps[0], ps[1], ps[2], ps[3], ps[4], ps[5], ps[6], ps[7]}, (size_t)7168 * 1024 * 2}; pg8::EpiSwiglu E{(pg8::bf16_t*)(ws + WS_MACT), DFFE, c0 * 256};
                        pg8::gemm_phase<pg8::EpiSwiglu, pg8::MoeOrder, false>(lds, g, S, E, nullptr); __syncthreads(); } PH_END
                    PH_BEGIN { pg8::Gemm g{(const pg8::bf16_t*)(ws + WS_MACT) - (size_t)c0 * 256 * DFFE, (const pg8::bf16_t*)(ws + WS_MW2), 0, 1024, DFFE};
                        pg8::MoeOrder S{nM, 4, c0, nblk, blk, {ps[0], ps[1], ps[2], ps[3], ps[4], ps[5], ps[6], ps[7]}, (size_t)1024 * DFFE * 2}; pg8::EpiBf16Out E{(pg8::bf16_t*)(ws + WS_XB), 1024};
                        pg8::gemm_phase<pg8::EpiBf16Out, pg8::MoeOrder, false>(lds, g, S, E, nullptr); __syncthreads(); } PH_END
                }
            }
            PH_BEGIN phase_moe_combine(a, gw, ngw, lane); PH_END
        }
    }
#ifdef DBG_SRC
    __builtin_amdgcn_fence(__ATOMIC_RELEASE, "agent"); grid.sync(); __builtin_amdgcn_fence(__ATOMIC_ACQUIRE, "agent");
    { const size_t n = (size_t)NLAT * 1024; const size_t gt = (size_t)blk0 * 512 + tid0, ng = (size_t)nblk * 512;
      if (DBG_KIND == 0) { const bf16* src = (const bf16*)(a0.ws + (size_t)DBG_SRC); for (size_t i = gt; i < n; i += ng) { a0.out[i] = (float)(src[i] & 7); } }
      else { const float* src = (const float*)(a0.ws + (size_t)DBG_SRC); for (size_t i = gt; i < n; i += ng) a0.out[i] = src[i % (size_t)DBG_N]; } }
#endif
}
constexpr int N_PHASES = 1 + 9 + 7 + 1 + 16 + 1;
#ifndef DBG_HI
#define DBG_HI (1 << 30)
#endif

extern "C" void kernel_launch(void* const* d_in, const int* in_sizes, int n_in, void* d_out, int out_size, void* d_ws, size_t ws_size, hipStream_t stream) {
    static int inited = 0;
    if (!inited) {
        if (hipFuncSetAttribute((const void*)mega, hipFuncAttributeMaxDynamicSharedMemorySize, LDS_BYTES) != hipSuccess) fprintf(stderr, "kernel_launch: hipFuncSetAttribute failed\n");
        inited = 1;
    }
    (void)hipMemsetAsync((char*)d_ws + WS_CTL, 0, 1048576, stream);
    Args a{};
    for (int i = 0; i < 25; ++i) a.in[i] = (const float*)d_in[i];
    a.out = (float*)d_out; a.ws = (unsigned char*)d_ws; a.lo = 0; a.hi = DBG_HI;
#ifdef MULTI_LAUNCH
    for (int p = 0; p < DBG_HI; p += MULTI_LAUNCH) { a.lo = p; a.hi = p + MULTI_LAUNCH < DBG_HI ? p + MULTI_LAUNCH : DBG_HI;
        void* args[] = {&a};
        hipError_t e = hipLaunchCooperativeKernel((const void*)mega, dim3(256), dim3(512), args, LDS_BYTES, stream);
        if (e != hipSuccess) { fprintf(stderr, "kernel_launch: cooperative launch failed: %s\n", hipGetErrorString(e)); break; } }
#else
    void* args[] = {&a};
    hipError_t e = hipLaunchCooperativeKernel((const void*)mega, dim3(256), dim3(512), args, LDS_BYTES, stream);
    if (e != hipSuccess) fprintf(stderr, "kernel_launch: cooperative launch failed: %s\n", hipGetErrorString(e));
#endif
}
```

```cpp
#include <hip/hip_runtime.h>
#include <hip/hip_cooperative_groups.h>
#include <cstdio>
namespace cg = cooperative_groups;
#define LAS __attribute__((address_space(3)))
typedef unsigned short bf16;
typedef short bf16x8 __attribute__((ext_vector_type(8)));
typedef float f32x4 __attribute__((ext_vector_type(4)));
typedef float f32x2 __attribute__((ext_vector_type(2)));
typedef unsigned u32x4 __attribute__((ext_vector_type(4)));
typedef unsigned u32x2 __attribute__((ext_vector_type(2)));

constexpr int DM = 1024, NLAT = 32768, NCTX = 512, NROW = 33280, SEQ = 16384, CTXL = 256;
constexpr int INW = 3088, DFF = 2816, DFFE = 3584, NEXP = 8;
constexpr float EPS = 1e-6f, LOG2E = 1.4426950408889634f;
constexpr int LDS_BYTES = 155648, NWG_WAVES = 8;

constexpr size_t MB = 1048576;
constexpr size_t WS_CTL = 0;
constexpr size_t CTL_MODV = 0;
constexpr size_t CTL_CNT = 160 * 1024;
constexpr size_t WS_TWID = 1 * MB;
constexpr size_t WS_F1 = WS_TWID + 131072;
constexpr size_t WS_A2 = WS_F1 + 65536;
constexpr size_t WS_A2C = WS_A2 + 131072;
constexpr size_t WS_WFT = WS_A2C + 262144;
constexpr size_t WS_GAB = 3 * MB;
constexpr size_t WS_CTXS = 6 * MB;
constexpr size_t WS_TOK = 8 * MB;
constexpr size_t WS_WIN = 10 * MB;
constexpr size_t WS_WOUT = 22 * MB;
constexpr size_t WS_W13 = 26 * MB;
constexpr size_t WS_W2 = 37 * MB;
constexpr size_t WS_HBUF = 43 * MB;
constexpr size_t WS_QKV = 108 * MB;
constexpr size_t WS_Z = 206 * MB;
constexpr size_t WS_NA = 239 * MB;
constexpr size_t WS_FT = 288 * MB;
constexpr size_t WS_VT = 305 * MB;
constexpr size_t WS_Y = 322 * MB;
constexpr size_t WS_DNS = 354 * MB;
constexpr size_t WS_DND = 484 * MB;
constexpr size_t WS_ACT = WS_DNS;
constexpr size_t WS_MW13 = 108 * MB;
constexpr size_t WS_MW2 = 220 * MB;
constexpr size_t WS_XB = 276 * MB;
constexpr size_t WS_MACT = 408 * MB;
constexpr size_t WS_SLOT = 9 * MB;
constexpr int MACT_ROWS = 16384;
constexpr int DNS_ITEM = 65536, DND_ITEM = 17408;

typedef __bf16 bf16x2_t __attribute__((ext_vector_type(2)));
__device__ __forceinline__ unsigned pk2(float lo, float hi) { bf16x2_t v = {(__bf16)lo, (__bf16)hi}; return __builtin_bit_cast(unsigned, v); }
__device__ __forceinline__ float bflo(unsigned u) { return __uint_as_float(u << 16); }
__device__ __forceinline__ float bfhi(unsigned u) { return __uint_as_float(u & 0xffff0000u); }
__device__ __forceinline__ float bf2f(bf16 b) { return __uint_as_float(((unsigned)b) << 16); }
__device__ __forceinline__ bf16 f2bf(float f) { return (bf16)(pk2(f, 0.f) & 0xffffu); }
__device__ __forceinline__ float wave_sum(float v) {
#pragma unroll
    for (int o = 1; o < 64; o <<= 1) v += __shfl_xor(v, o);
    return v;
}
__device__ __forceinline__ float silu_f(float v) { return v / (1.f + __expf(-v)); }
__device__ __forceinline__ bf16x8 mk8(unsigned a, unsigned b, unsigned c, unsigned d) { u32x4 v = {a, b, c, d}; return __builtin_bit_cast(bf16x8, v); }
__device__ __forceinline__ bf16x8 pack8(f32x4 a, f32x4 b) { return mk8(pk2(a[0], a[1]), pk2(a[2], a[3]), pk2(b[0], b[1]), pk2(b[2], b[3])); }
#define MFMA16(a, b, c) __builtin_amdgcn_mfma_f32_16x16x32_bf16((a), (b), (c), 0, 0, 0)
#define LDS_WAIT() asm volatile("s_waitcnt lgkmcnt(0)" ::: "memory")
#define VM_WAIT() asm volatile("s_waitcnt vmcnt(0)" ::: "memory")
__device__ __forceinline__ bf16x8 lds_tr8(unsigned addr, unsigned addr2) {
    u32x2 a, b;
    asm volatile("ds_read_b64_tr_b16 %0, %2\n\tds_read_b64_tr_b16 %1, %3\n\ts_waitcnt lgkmcnt(0)" : "=&v"(a), "=&v"(b) : "v"(addr), "v"(addr2) : "memory");
    return mk8(a.x, a.y, b.x, b.y);
}

__device__ __forceinline__ u32x2 tr_issue(unsigned addr) { u32x2 r; asm volatile("ds_read_b64_tr_b16 %0, %1" : "=v"(r) : "v"(addr) : "memory"); return r; }
__device__ __forceinline__ void tr_wait8(u32x2& a, u32x2& b, u32x2& c, u32x2& d, u32x2& e, u32x2& f, u32x2& g, u32x2& h) {
    asm volatile("s_waitcnt lgkmcnt(0)" : "+v"(a), "+v"(b), "+v"(c), "+v"(d), "+v"(e), "+v"(f), "+v"(g), "+v"(h) :: "memory"); }

struct Args {
    const float* in[25];
    float* out;
    unsigned char* ws;
    int lo, hi;
};
namespace pg8 {
#define PG8_LAS __attribute__((address_space(3)))
typedef unsigned short bf16_t;
typedef short bf16x8 __attribute__((ext_vector_type(8)));
typedef float f32x4 __attribute__((ext_vector_type(4)));
typedef unsigned u32x4 __attribute__((ext_vector_type(4)));
constexpr int BM = 256, BK = 64, HALF = 128, HTB = HALF * BK * 2  , STAGE_BYTES = 8 * HTB, NXCD = 8, WGM = 8;

__host__ __device__ __forceinline__ int lds_byte(int r, int c) { const int st = (r >> 4) * 2 + (c >> 5), rr = r & 15, cc = c & 31, ob = rr * 64 + cc * 2; return st * 1024 + (ob ^ (((ob >> 9) & 1) << 5)); }
__host__ __device__ __forceinline__ void stage_rc(int b, int& R, int& C) { const int st = b / 1024, sb = b % 1024, swz = sb ^ (((sb >> 9) & 1) << 5); R = (st >> 1) * 16 + swz / 64; C = (st & 1) * 32 + (swz % 64) / 2; }
__host__ __device__ __forceinline__ int perm32(int rho) { const int n = rho >> 4, i = rho & 15; return 8 * (i >> 2) + 4 * n + (i & 3); }

struct Unit { int pm, pn; };
struct Gemm { const bf16_t* A; const bf16_t* Bt; int M, N, K; };

struct StaticOrder {
    int nM, nN, nwg, G, c;
    __host__ __device__ void init(int M, int N, int G_, int c_) { nM = M / BM; nN = N / BM; nwg = nM * nN; G = G_; c = c_; }
    __host__ __device__ bool next(int i, Unit& u) const {
        const long L = (long)i * G + c; if (L >= nwg) return false;
        int wgid = (int)L; { const int q = nwg / NXCD, r = nwg % NXCD, xcd = wgid % NXCD, off = wgid / NXCD; wgid = (xcd < r ? xcd * (q + 1) : r * (q + 1) + (xcd - r) * q) + off; }
        const int nig = WGM * nN, gid = wgid / nig, fm = gid * WGM, gsz = (nM - fm) < WGM ? (nM - fm) : WGM;
        u.pm = fm + ((wgid % nig) % gsz); u.pn = (wgid % nig) / gsz; return true;
    }
    __device__ __forceinline__ void a_ready(const Unit&) const {}
    __device__ __forceinline__ void done(const Unit&) const {}
    __device__ __forceinline__ const char* bptr(const Gemm& g, const Unit& u, size_t tstep) const { return (const char*)g.Bt + (size_t)u.pn * tstep; }
};
__device__ __forceinline__ unsigned cvt_pk_bf16(float lo, float hi) { return pk2(lo, hi); }
template <class Epi, class Sched, bool STAMP = false>
__device__ __forceinline__ void gemm_phase(PG8_LAS unsigned char* lds, const Gemm g, const Sched& S, const Epi& E, unsigned long long* stamps) {
    int tid_l = threadIdx.x; asm volatile("" : "+v"(tid_l)); const int tid = tid_l, wid = __builtin_amdgcn_readfirstlane(tid >> 6), lane = tid & 63, wr = wid >> 2, wc = wid & 3, fr = lane & 15, fq = lane >> 4;
    const int K = g.K, nt = K / BK;
    int ts_lo = 0, ts_hi = 0, nts = 0; const unsigned long long rt_entry = STAMP ? (unsigned long long)wall_clock64() : 0ull;
#define PG8_STAMP() do { if (STAMP && wid == 0 && nts < 64) { const unsigned long long _c = (unsigned long long)clock64(); \
        ts_lo = (lane == nts) ? (int)(unsigned)_c : ts_lo; ts_hi = (lane == nts) ? (int)(unsigned)(_c >> 32) : ts_hi; ++nts; } } while (0)
    PG8_STAMP();
    unsigned voffA[2], voffB[2];
#pragma unroll
    for (int i = 0; i < 2; ++i) { int R, C; stage_rc(tid * 16 + i * 8192, R, C); const int Rb = Epi::PERM ? ((R & ~31) + perm32(R & 31)) : R;
        voffA[i] = (unsigned)(R * K + C) * 2u; voffB[i] = (unsigned)(Rb * K + C) * 2u; }
    const size_t kstep = (size_t)(BK * 2);
    const size_t hstep = (size_t)HALF * K * 2;
    const size_t tstep = 2 * hstep;
    const unsigned ldsw = (unsigned)wid * 1024u;
    const int aoff = lds_byte(wr * 64 + fr, fq * 8), boff = lds_byte(wc * 32 + fr, fq * 8);
#define PG8_SA(b, h) (((b) * 2 + (h)) * HTB)
#define PG8_SB(b, h) ((4 + (b) * 2 + (h)) * HTB)
#define PG8_STAGE(bufoff, gbase, voff) do { _Pragma("unroll") for (int _i = 0; _i < 2; ++_i) \
        __builtin_amdgcn_global_load_lds((const unsigned*)((const char*)(gbase) + (voff)[_i]), (PG8_LAS unsigned*)(lds + (bufoff) + ldsw + _i * 8192), 16, 0, 0); } while (0)
#define PG8_STAGEA(bufoff, gbase, voff) do { _Pragma("unroll") for (int _i = 0; _i < 2; ++_i) \
        __builtin_amdgcn_global_load_lds((const unsigned*)((const char*)(gbase) + (voff)[_i]), (PG8_LAS unsigned*)(lds + (bufoff) + ldsw + _i * 8192), 16, 0, 16); } while (0)
#define PG8_LDA(dst, b, h) do { _Pragma("unroll") for (int m = 0; m < 4; ++m) _Pragma("unroll") for (int k = 0; k < 2; ++k) dst[m][k] = *(const PG8_LAS bf16x8*)(lds + PG8_SA(b, h) + aoff + m * 2048 + k * 1024); } while (0)
#define PG8_LDB(dst, b, h) do { _Pragma("unroll") for (int n = 0; n < 2; ++n) _Pragma("unroll") for (int k = 0; k < 2; ++k) dst[n][k] = *(const PG8_LAS bf16x8*)(lds + PG8_SB(b, h) + boff + n * 2048 + k * 1024); } while (0)
#define PG8_MMA(ai, bj, At, Bt) do { __builtin_amdgcn_s_setprio(1); _Pragma("unroll") for (int m = 0; m < 4; ++m) _Pragma("unroll") for (int n = 0; n < 2; ++n) _Pragma("unroll") for (int k = 0; k < 2; ++k) \
        acc[ai][bj][m][n] = __builtin_amdgcn_mfma_f32_16x16x32_bf16(Bt[n][k], At[m][k], acc[ai][bj][m][n], 0, 0, 0); __builtin_amdgcn_s_setprio(0); } while (0)
#define PG8_WAIT_V(n) asm volatile("s_waitcnt vmcnt(" #n ")" ::: "memory")
#define PG8_WAIT_L(n) asm volatile("s_waitcnt lgkmcnt(" #n ")" ::: "memory")
#define PG8_BAR __builtin_amdgcn_s_barrier()
#define PG8_SCHED __builtin_amdgcn_sched_barrier(0)
    Unit cur, nxt; int ui = 0;
    if (!S.next(0, cur)) return;
    f32x4 acc[2][2][4][2];
#pragma unroll
    for (int a = 0; a < 2; ++a)
#pragma unroll
        for (int b = 0; b < 2; ++b)
#pragma unroll
            for (int m = 0; m < 4; ++m)
#pragma unroll
                for (int n = 0; n < 2; ++n) acc[a][b][m][n] = (f32x4){0.f, 0.f, 0.f, 0.f};
    bf16x8 At[4][2], B0[2][2], B1[2][2];
    const char* cA = (const char*)g.A + (size_t)cur.pm * tstep; const char* cB = S.bptr(g, cur, tstep);
    S.a_ready(cur);
    PG8_STAGE(PG8_SB(0, 0), cB, voffB); PG8_STAGEA(PG8_SA(0, 0), cA, voffA); PG8_STAGE(PG8_SB(0, 1), cB + hstep, voffB); PG8_STAGEA(PG8_SA(0, 1), cA + hstep, voffA);
    if (wr == 1) PG8_BAR;
    PG8_WAIT_V(4); PG8_BAR;
    PG8_STAGE(PG8_SB(1, 0), cB + kstep, voffB); PG8_STAGEA(PG8_SA(1, 0), cA + kstep, voffA); PG8_STAGE(PG8_SB(1, 1), cB + hstep + kstep, voffB);
    PG8_WAIT_V(6); PG8_BAR;
    PG8_STAMP();
    for (;;) {
        const bool has_next = S.next(ui + 1, nxt);
        const char* nA = has_next ? (const char*)g.A + (size_t)nxt.pm * tstep : cA; const char* nB = has_next ? S.bptr(g, nxt, tstep) : cB;
        for (int t = 0; t < nt; t += 2) {
            const bool last = (t == nt - 2);
            const char* a1 = cA + (size_t)(t + 1) * kstep;
            const char* a2 = last ? nA : cA + (size_t)(t + 2) * kstep; const char* b2 = last ? nB : cB + (size_t)(t + 2) * kstep;
            const char* a3 = a2 + kstep; const char* b3 = b2 + kstep;
            if (last && has_next) S.a_ready(nxt);
            PG8_LDB(B0, 0, 0); PG8_SCHED; PG8_LDA(At, 0, 0); PG8_STAGEA(PG8_SA(1, 1), a1 + hstep, voffA);
            PG8_WAIT_L(8); PG8_BAR; PG8_WAIT_L(0); PG8_MMA(0, 0, At, B0); PG8_BAR; PG8_SCHED;
            PG8_LDB(B1, 0, 1); PG8_STAGE(PG8_SB(0, 0), b2, voffB);
            PG8_BAR; PG8_WAIT_L(0); PG8_MMA(0, 1, At, B1); PG8_BAR;
            PG8_LDA(At, 0, 1); PG8_STAGEA(PG8_SA(0, 0), a2, voffA);
            PG8_BAR; PG8_WAIT_L(0); PG8_MMA(1, 0, At, B0); PG8_BAR; PG8_SCHED;
            PG8_STAGE(PG8_SB(0, 1), b2 + hstep, voffB);
            PG8_WAIT_V(6); PG8_BAR; PG8_MMA(1, 1, At, B1); PG8_BAR;
            PG8_LDB(B0, 1, 0); PG8_SCHED; PG8_LDA(At, 1, 0); PG8_STAGEA(PG8_SA(0, 1), a2 + hstep, voffA);
            PG8_WAIT_L(8); PG8_BAR; PG8_WAIT_L(0); PG8_MMA(0, 0, At, B0); PG8_BAR; PG8_SCHED;
            PG8_LDB(B1, 1, 1); PG8_STAGE(PG8_SB(1, 0), b3, voffB);
            PG8_BAR; PG8_WAIT_L(0); PG8_MMA(0, 1, At, B1); PG8_BAR;
            PG8_LDA(At, 1, 1); PG8_STAGEA(PG8_SA(1, 0), a3, voffA);
            PG8_BAR; PG8_WAIT_L(0); PG8_MMA(1, 0, At, B0); PG8_BAR; PG8_SCHED;
            PG8_STAGE(PG8_SB(1, 1), b3 + hstep, voffB);
            PG8_WAIT_V(6); PG8_BAR; PG8_MMA(1, 1, At, B1); PG8_BAR;
        }
        PG8_STAMP();
        if constexpr (!Epi::AFTER_DRAIN) { E(acc, cur, wr, wc, fr, fq); S.done(cur); }
        PG8_STAMP();
        if (!has_next) break;
#pragma unroll
        for (int a = 0; a < 2; ++a)
#pragma unroll
            for (int b = 0; b < 2; ++b)
#pragma unroll
                for (int m = 0; m < 4; ++m)
#pragma unroll
                    for (int n = 0; n < 2; ++n) acc[a][b][m][n] = (f32x4){0.f, 0.f, 0.f, 0.f};
        cur = nxt; cA = nA; cB = nB; ++ui;
    }
    PG8_WAIT_V(0);
    if (wr == 0) PG8_BAR;
    PG8_BAR;
    if constexpr (Epi::AFTER_DRAIN) { E.fused(acc, cur, wr, wc, fr, fq, lds, wid, lane); S.done(cur); }
    PG8_STAMP();
    if (STAMP && wid == 0) { stamps[lane] = lane < nts ? (((unsigned long long)(unsigned)ts_hi << 32) | (unsigned)ts_lo) : 0ull;
        if (lane == 62) stamps[62] = rt_entry; if (lane == 63) stamps[63] = (unsigned long long)wall_clock64(); }
#undef PG8_STAMP
#undef PG8_SA
#undef PG8_SB
#undef PG8_STAGE
#undef PG8_STAGEA
#undef PG8_LDA
#undef PG8_LDB
#undef PG8_MMA
#undef PG8_WAIT_V
#undef PG8_WAIT_L
#undef PG8_BAR
#undef PG8_SCHED
}
}
#define XB_TMO      128
#define XB_XCNT(j)  (256  + 64 * (j))
#define XB_XSUB(j)  (1280 + 64 * (j))
#define XB_XGEN(j)  (2304 + 64 * (j))
#define XB_TOP      3328
#define XB_TOPGEN   3392
#define XCD_BAR_WORDS 3456
#define XB_SPIN_CAP (1u << 18)

__device__ __forceinline__ unsigned xb_ld(unsigned* p)              { return __hip_atomic_load(p, __ATOMIC_RELAXED, __HIP_MEMORY_SCOPE_AGENT); }
__device__ __forceinline__ unsigned xb_add(unsigned* p, unsigned v) { return __hip_atomic_fetch_add(p, v, __ATOMIC_RELAXED, __HIP_MEMORY_SCOPE_AGENT); }
__device__ __forceinline__ unsigned xb_xcc_id() { return (unsigned)__builtin_amdgcn_s_getreg((3 << 11) | 20) & 0xFu; }
#define XB_SPIN(cond, bar) do { unsigned _sp = 0; while (cond) { __builtin_amdgcn_s_sleep(1); \
    if ((++_sp & 255u) == 0u) { if (xb_ld(&(bar)[XB_TMO])) break; if (_sp > XB_SPIN_CAP) { atomicAdd(&(bar)[XB_TMO], 1u); break; } } } } while (0)

struct XcdBarrier {
    unsigned* bar; unsigned x;
    volatile LAS unsigned* st;
};

__device__ __forceinline__ XcdBarrier xcd_barrier_post(unsigned* bar, volatile LAS unsigned* st) {
    XcdBarrier b; b.bar = bar; b.x = xb_xcc_id(); b.st = st;
    if (threadIdx.x == 0) (void)xb_add(&bar[XB_XCNT(b.x)], 1u);
    return b;
}
__device__ __forceinline__ void xcd_barrier_complete(unsigned* bar, unsigned x, unsigned& nloc, unsigned& nx) {
    const unsigned G = gridDim.x * gridDim.y * gridDim.z;
    unsigned sum, cnt, mine, sp = 0u;
    for (;;) {
        sum = 0u; cnt = 0u; mine = 0u;
#pragma unroll
        for (unsigned j = 0; j < 16; ++j) { const unsigned c = xb_ld(&bar[XB_XCNT(j)]); sum += c; cnt += (c > 0u) ? 1u : 0u; mine = (j == x) ? c : mine; }
        if (sum == G) break;
        __builtin_amdgcn_s_sleep(1);
        if ((++sp & 255u) == 0u) { if (xb_ld(&bar[XB_TMO])) break; if (sp > XB_SPIN_CAP) { atomicAdd(&bar[XB_TMO], 1u); break; } }
    }
    nloc = mine > 0u ? mine : 1u; nx = cnt > 0u ? cnt : 1u;
}

__device__ __forceinline__ void xcd_barrier(const XcdBarrier& b) {
    asm volatile("s_waitcnt vmcnt(0)" ::: "memory");
    __syncthreads();
    if (threadIdx.x == 0) {
        unsigned* bar = b.bar;
        __builtin_amdgcn_s_waitcnt(0);
        unsigned nloc = b.st[0], nx = b.st[1];
        if (nloc == 0u) { xcd_barrier_complete(bar, b.x, nloc, nx); b.st[0] = nloc; b.st[1] = nx; }
        const unsigned old = xb_add(&bar[XB_XSUB(b.x)], 1u);
        const unsigned gen = old / nloc;
        if (old + 1u == (gen + 1u) * nloc) {
            __builtin_amdgcn_fence(__ATOMIC_RELEASE, "agent");
            asm volatile("s_waitcnt vmcnt(0)" ::: "memory");
            const unsigned og = xb_add(&bar[XB_TOP], 1u);
            const unsigned tg = og / nx;
            if (og + 1u == (tg + 1u) * nx) xb_add(&bar[XB_TOPGEN], 1u);
            else XB_SPIN(xb_ld(&bar[XB_TOPGEN]) == tg, bar);
            __builtin_amdgcn_fence(__ATOMIC_ACQUIRE, "agent");
            xb_add(&bar[XB_XGEN(b.x)], 1u);
            asm volatile("s_waitcnt vmcnt(0)" ::: "memory");
        } else {
            XB_SPIN(xb_ld(&bar[XB_XGEN(b.x)]) == gen, bar);
            __builtin_amdgcn_fence(__ATOMIC_ACQUIRE, "agent");
            asm volatile("s_waitcnt vmcnt(0)" ::: "memory");
        }
    }
    __syncthreads();
}

__device__ __forceinline__ void tr_item(const float* W, int ldn, int k0, int nsrc0, bf16* dst, int ldk, LAS float* scr, int lane) {
    const int r = lane >> 4, c4 = lane & 15;
    f32x4 v[16];
#pragma unroll
    for (int i = 0; i < 16; ++i) v[i] = __builtin_nontemporal_load((const f32x4*)(W + (size_t)(k0 + 4 * i + r) * ldn + nsrc0 + 4 * c4));
#pragma unroll
    for (int i = 0; i < 16; ++i) { LAS float* d = scr + (4 * i + r) * 65 + 4 * c4; d[0] = v[i][0]; d[1] = v[i][1]; d[2] = v[i][2]; d[3] = v[i][3]; }
    LDS_WAIT();
    const int c = lane & 7;
#pragma unroll
    for (int j = 0; j < 8; ++j) { const int n = (lane >> 3) + 8 * j; const LAS float* s = scr + (8 * c) * 65 + n;
        u32x4 o; o.x = pk2(s[0 * 65], s[1 * 65]); o.y = pk2(s[2 * 65], s[3 * 65]); o.z = pk2(s[4 * 65], s[5 * 65]); o.w = pk2(s[6 * 65], s[7 * 65]);
        *(u32x4*)(dst + (size_t)n * ldk + k0 + 8 * c) = o; }
    LDS_WAIT();
}
__device__ __forceinline__ int w13_row(int f) { return 256 * (f >> 7) + (f & 127); }

__device__ __forceinline__ void phase_prologue(const Args& a, LAS unsigned char* lds, int gw, int ngw, int wave, int lane, int gtid, int ngt) {
    unsigned char* ws = a.ws;
    LAS float* scr = (LAS float*)(lds + wave * 16640);
    constexpr int N_GEMV = 1536, I_WIN = 768, I_WOUT = 256, I_W1 = 704, I_W2 = 704;
    constexpr int N_ITEMS = N_GEMV + 2 * I_WIN + 2 * I_WOUT + 2 * I_W1 + I_W2;
    { LAS float* sl = (LAS float*)(lds + 133120);
        for (int i = threadIdx.x; i < 3072; i += 512) { const float v = i < 2048 ? a.in[1][i] : a.in[3][i - 2048]; sl[i] = silu_f(v); }
        __syncthreads(); }
    for (int it = gw; it < N_ITEMS; it += ngw) {
        int r = it;
        if (r < N_GEMV) {
            const int grp = r >> 3, kq = r & 7, l = grp / 96, cb = grp % 96, col = 64 * cb + lane;
            const float* wm = a.in[4] + (size_t)l * 1024 * 6144 + (size_t)(128 * kq) * 6144 + col;
            const LAS float* sl = (const LAS float*)(lds + 133120) + 128 * kq;
            float a0[4] = {0.f, 0.f, 0.f, 0.f}, a1[4] = {0.f, 0.f, 0.f, 0.f}, a2[4] = {0.f, 0.f, 0.f, 0.f};
#pragma unroll 4
            for (int k = 0; k < 128; k += 4) {
#pragma unroll
                for (int u = 0; u < 4; ++u) { const float w = wm[(size_t)(k + u) * 6144];
                    a0[u] += sl[k + u] * w; a1[u] += sl[1024 + k + u] * w; a2[u] += sl[2048 + k + u] * w; }
            }
            float* part = (float*)(ws + WS_GAB) + (size_t)r * 192;
            part[lane] = (a0[0] + a0[1]) + (a0[2] + a0[3]); part[64 + lane] = (a1[0] + a1[1]) + (a1[2] + a1[3]); part[128 + lane] = (a2[0] + a2[1]) + (a2[2] + a2[3]);
            __builtin_amdgcn_fence(__ATOMIC_RELEASE, "agent");
            unsigned old = 0; if (lane == 0) old = __hip_atomic_fetch_add((unsigned*)(ws + WS_CTL + 540672) + grp, 1u, __ATOMIC_RELAXED, __HIP_MEMORY_SCOPE_AGENT);
            old = __shfl(old, 0);
            if (old == 7u) { __builtin_amdgcn_fence(__ATOMIC_ACQUIRE, "agent");
                const float* pg = (const float*)(ws + WS_GAB) + (size_t)grp * 8 * 192; const float b = a.in[5][l * 6144 + col];
                float s0 = 0.f, s1 = 0.f, s2 = 0.f;
#pragma unroll
                for (int q = 0; q < 8; ++q) { s0 += __hip_atomic_load(pg + q * 192 + lane, __ATOMIC_RELAXED, __HIP_MEMORY_SCOPE_AGENT); s1 += __hip_atomic_load(pg + q * 192 + 64 + lane, __ATOMIC_RELAXED, __HIP_MEMORY_SCOPE_AGENT); s2 += __hip_atomic_load(pg + q * 192 + 128 + lane, __ATOMIC_RELAXED, __HIP_MEMORY_SCOPE_AGENT); }
                float* mv = (float*)(ws + WS_CTL + CTL_MODV) + (size_t)l * 3 * 6144 + col;
                mv[0] = s0 + b; mv[6144] = s1 + b; mv[2 * 6144] = s2 + b; }
            continue;
        }
        r -= N_GEMV;
        if (r < 2 * I_WIN) { const int l = r / I_WIN, q = r % I_WIN, kb = q / 48, nb = q % 48, n0 = 64 * nb;
            tr_item(a.in[8] + (size_t)l * 1024 * INW, INW, 64 * kb, n0 + (n0 >= 2048 ? 16 : 0), (bf16*)(ws + WS_WIN) + ((size_t)l * 3072 + n0) * 1024, 1024, scr, lane); continue; }
        r -= 2 * I_WIN;
        if (r < 2 * I_WOUT) { const int l = r / I_WOUT, q = r % I_WOUT, kb = q / 16, nb = q % 16;
            tr_item(a.in[17] + (size_t)l * 1024 * 1024, 1024, 64 * kb, 64 * nb, (bf16*)(ws + WS_WOUT) + ((size_t)l * 1024 + 64 * nb) * 1024, 1024, scr, lane); continue; }
        r -= 2 * I_WOUT;
        if (r < 2 * I_W1) { const int which = r / I_W1, q = r % I_W1, kb = q / 44, nb = q % 44;
            tr_item(a.in[which ? 19 : 18], DFF, 64 * kb, 64 * nb, (bf16*)(ws + WS_W13) + (size_t)(w13_row(64 * nb) + 128 * which) * 1024, 1024, scr, lane); continue; }
        r -= 2 * I_W1;
        { const int kb = r / 16, nb = r % 16;
            tr_item(a.in[20], 1024, 64 * kb, 64 * nb, (bf16*)(ws + WS_W2) + (size_t)(64 * nb) * DFF, DFF, scr, lane); }
    }
    for (int i = gtid; i < 16384; i += ngt) { float s, c; sincospif((float)i * (1.0f / 8192.0f), &s, &c); ((f32x2*)(ws + WS_TWID))[i] = (f32x2){c, s}; }
    for (int i = gtid; i < 32768; i += ngt) { const int row = i >> 7, t1 = i & 127, c = row >> 7, kb = row & 127; const float ang = (float)((kb * t1) & 127) * (1.0f / 64.0f);
        ((bf16*)(ws + WS_F1))[i] = f2bf(c == 0 ? cospif(ang) : -sinpif(ang)); }
    for (int i = gtid; i < 65536; i += ngt) { const int row = i >> 8, col = i & 255, c = row >> 7, ka = row & 127, c2 = col >> 7, t0 = col & 127; const float ang = (float)((ka * t0) & 127) * (1.0f / 64.0f);
        const float cs = cospif(ang), sn = sinpif(ang); ((bf16*)(ws + WS_A2))[i] = f2bf(c == c2 ? cs : (c == 0 ? sn : -sn)); }
    for (int i = gtid; i < 131072; i += ngt) { const int kh = i >> 16, row = (i >> 8) & 255, t = i & 255, c = row >> 7, ka = row & 127, k = 128 * kh + ka; const float ang = (float)((k * t) & 255) * (1.0f / 128.0f);
        ((bf16*)(ws + WS_A2C))[i] = f2bf(c == 0 ? cospif(ang) : -sinpif(ang)); }
    for (int i = gtid; i < 262144; i += ngt) { const int l = i >> 17, mt = (i >> 13) & 15, kk = (i >> 9) & 15, ln = (i >> 3) & 63, e = i & 7;
        const int j = 16 * mt + (ln & 15), g = ln >> 4, kidx = 32 * kk + (e < 4 ? 4 * g + e : 16 + 4 * g + e - 4), c = kidx >> 8, ch = kidx & 255, grp = ch >> 6, n = ch & 63;
        const float* fw = a.in[16] + (size_t)l * 65536 + (size_t)(grp * 64) * 256 + j; float s = 0.f;
        for (int m = 0; m < 64; ++m) { const float ang = (float)((m * n) & 63) * (1.0f / 32.0f); s += (c == 0 ? cospif(ang) : sinpif(ang)) * fw[m * 256]; }
        ((bf16*)(ws + WS_WFT))[i] = f2bf(s * (1.0f / 1024.0f)); }
}

__device__ __forceinline__ void phase_A(const Args& a, int l, LAS unsigned char* lds, int gw, int ngw, int tid, int lane) {
    unsigned char* ws = a.ws;
    LAS float* wab = (LAS float*)lds;
    const float* win = a.in[8] + (size_t)l * 1024 * INW + 2048;
    for (int i = tid; i < 16384; i += 512) { const int k = i >> 4, o = i & 15; wab[o * 1024 + k] = win[(size_t)k * INW + o]; }
    __syncthreads();
    const float* gm = a.in[6] + l * 1024;
    const float* modv = (const float*)(ws + WS_CTL + CTL_MODV) + (size_t)l * 3 * 6144;
    const float* xl = l == 0 ? a.in[0] : a.out; const float* xc = l == 0 ? a.in[2] : (const float*)(ws + WS_CTXS);
    bf16* hb = (bf16*)(ws + WS_HBUF); float* gab = (float*)(ws + WS_GAB);
    f32x4 nv[4];
    { const int row = gw < NROW ? gw : 0; const float* xr = row < NLAT ? xl + (size_t)row * 1024 : xc + (size_t)(row - NLAT) * 1024;
#pragma unroll
        for (int j = 0; j < 4; ++j) nv[j] = *(const f32x4*)(xr + 4 * lane + 256 * j); }
    for (int row = gw; row < NROW; row += ngw) {
        const int bi = row < NLAT ? (row >> 14) : 2; const float* md = modv + bi * 6144;
        f32x4 v[4]; float ss = 0.f;
#pragma unroll
        for (int j = 0; j < 4; ++j) v[j] = nv[j];
        { const int rn = row + ngw < NROW ? row + ngw : row; const float* xn = rn < NLAT ? xl + (size_t)rn * 1024 : xc + (size_t)(rn - NLAT) * 1024;
#pragma unroll
            for (int j = 0; j < 4; ++j) nv[j] = *(const f32x4*)(xn + 4 * lane + 256 * j); }
#pragma unroll
        for (int j = 0; j < 4; ++j) ss += (v[j][0] * v[j][0] + v[j][1] * v[j][1]) + (v[j][2] * v[j][2] + v[j][3] * v[j][3]);
        const float rinv = rsqrtf(wave_sum(ss) * (1.0f / 1024.0f) + EPS);
        float p[16];
#pragma unroll
        for (int o = 0; o < 16; ++o) p[o] = 0.f;
#pragma unroll
        for (int j = 0; j < 4; ++j) { const int k = 4 * lane + 256 * j; const f32x4 g4 = *(const f32x4*)(gm + k), sc = *(const f32x4*)(md + 1024 + k), sh = *(const f32x4*)(md + k);
            f32x4 h = v[j] * rinv * g4 * (sc + 1.0f) + sh; v[j] = h;
            *(u32x2*)(hb + (size_t)row * 1024 + k) = (u32x2){pk2(h[0], h[1]), pk2(h[2], h[3])};
#pragma unroll
            for (int o = 0; o < 16; ++o) { const f32x4 w4 = *(const LAS f32x4*)(wab + o * 1024 + k); p[o] += (h[0] * w4[0] + h[1] * w4[1]) + (h[2] * w4[2] + h[3] * w4[3]); } }
        float mine = 0.f;
#pragma unroll
        for (int o = 0; o < 16; ++o) { const float s = wave_sum(p[o]); if (lane == o) mine = s; }
        if (lane < 8) { const float al = mine + a.in[11][l * 8 + lane]; const float sp = fmaxf(al, 0.f) + log1pf(__expf(-fabsf(al)));
            gab[(size_t)row * 16 + lane] = -__expf(a.in[10][l * 8 + lane]) * sp; }
        else if (lane < 16) gab[(size_t)row * 16 + lane] = 1.0f / (1.0f + __expf(-mine));
    }
    __syncthreads();
}
__device__ __forceinline__ void phase_F(const Args& a, int l, LAS unsigned char* lds, int gw, int ngw, int tid, int lane) {
    unsigned char* ws = a.ws;
    LAS float* wrt = (LAS float*)lds;
    if (l == 1) { for (int i = tid; i < 8192; i += 512) { const int k = i >> 3, e = i & 7; wrt[e * 1024 + k] = a.in[21][i]; } __syncthreads(); }
    const float* gm = a.in[7] + l * 1024;
    const float* modv = (const float*)(ws + WS_CTL + CTL_MODV) + (size_t)l * 3 * 6144;
    const float* xl = a.out; const float* xc = (const float*)(ws + WS_CTXS);
    bf16* hb = (bf16*)(ws + WS_HBUF);
    int* tok_e = (int*)(ws + WS_TOK); float* tok_w = (float*)(ws + WS_TOK + 262144);
    const int nrow = l == 0 ? NROW : NLAT; int mycnt = 0;
    const int per = (nrow + ngw - 1) / ngw;
    f32x4 nv[4];
    { const int row = gw * per < nrow ? gw * per : 0; const float* xr = row < NLAT ? xl + (size_t)row * 1024 : xc + (size_t)(row - NLAT) * 1024;
#pragma unroll
        for (int j = 0; j < 4; ++j) nv[j] = *(const f32x4*)(xr + 4 * lane + 256 * j); }
    for (int row = gw * per; row < gw * per + per && row < nrow; ++row) {
        const int bi = row < NLAT ? (row >> 14) : 2; const float* md = modv + bi * 6144;
        f32x4 v[4]; float ss = 0.f;
#pragma unroll
        for (int j = 0; j < 4; ++j) v[j] = nv[j];
        { const int rn = row + 1 < nrow ? row + 1 : row; const float* xn = rn < NLAT ? xl + (size_t)rn * 1024 : xc + (size_t)(rn - NLAT) * 1024;
#pragma unroll
            for (int j = 0; j < 4; ++j) nv[j] = *(const f32x4*)(xn + 4 * lane + 256 * j); }
#pragma unroll
        for (int j = 0; j < 4; ++j) ss += (v[j][0] * v[j][0] + v[j][1] * v[j][1]) + (v[j][2] * v[j][2] + v[j][3] * v[j][3]);
        const float rinv = rsqrtf(wave_sum(ss) * (1.0f / 1024.0f) + EPS);
        float p[8];
#pragma unroll
        for (int o = 0; o < 8; ++o) p[o] = 0.f;
#pragma unroll
        for (int j = 0; j < 4; ++j) { const int k = 4 * lane + 256 * j; const f32x4 g4 = *(const f32x4*)(gm + k), sc = *(const f32x4*)(md + 4096 + k), sh = *(const f32x4*)(md + 3072 + k);
            const f32x4 h = v[j] * rinv * g4 * (sc + 1.0f) + sh;
            *(u32x2*)(hb + (size_t)row * 1024 + k) = (u32x2){pk2(h[0], h[1]), pk2(h[2], h[3])};
            if (l == 1) {
#pragma unroll
                for (int o = 0; o < 8; ++o) { const f32x4 w4 = *(const LAS f32x4*)(wrt + o * 1024 + k); p[o] += (h[0] * w4[0] + h[1] * w4[1]) + (h[2] * w4[2] + h[3] * w4[3]); } } }
        if (l == 1) {
            float lg[8];
#pragma unroll
            for (int o = 0; o < 8; ++o) lg[o] = wave_sum(p[o]);
            int e0 = 0; float l0 = lg[0];
#pragma unroll
            for (int o = 1; o < 8; ++o) if (lg[o] > l0) { l0 = lg[o]; e0 = o; }
            int e1 = -1; float l1 = -3.0e38f;
#pragma unroll
            for (int o = 0; o < 8; ++o) if (o != e0 && lg[o] > l1) { l1 = lg[o]; e1 = o; }
            const float w1 = 1.0f / (1.0f + __expf(l0 - l1)), w0 = 1.0f - w1;
            if (lane == 0) { tok_e[2 * row] = e0; tok_e[2 * row + 1] = e1; tok_w[2 * row] = w0; tok_w[2 * row + 1] = w1; }
            mycnt += (lane == e0) + (lane == e1);
        }
    }
    if (l == 1 && lane < 8 && mycnt > 0) atomicAdd((int*)(ws + WS_CTL + CTL_CNT) + lane, mycnt);
    if (l == 1 && lane < 8) ((int*)(ws + WS_CTL + 262144))[gw * 8 + lane] = mycnt;
    __syncthreads();
}
namespace pg8 {
struct EpiProj {
    static constexpr bool PERM = true, AFTER_DRAIN = false; unsigned char* ws;
    __device__ __forceinline__ void operator()(const f32x4 (&acc)[2][2][4][2], const Unit& u, int wr, int wc, int fr, int fq) const {
        const int row0 = u.pm * BM + wr * 64 + fr, pn = u.pn; bf16_t* base; int ldc, colt;
        if (pn < 6) { base = (bf16_t*)(ws + WS_QKV); ldc = 1536; colt = pn * 256; } else if (pn < 8) { base = (bf16_t*)(ws + WS_Z); ldc = 512; colt = (pn - 6) * 256; }
        else if (pn < 11) { base = (bf16_t*)(ws + WS_NA); ldc = 768; colt = (pn - 8) * 256; } else { base = (bf16_t*)(ws + WS_FT); ldc = 256; colt = 0; }
        const int col0 = colt + wc * 32 + 8 * fq;
#pragma unroll
        for (int ai = 0; ai < 2; ++ai)
#pragma unroll
            for (int m = 0; m < 4; ++m) { bf16_t* rowp = base + (size_t)(row0 + ai * HALF + m * 16) * ldc + col0;
#pragma unroll
                for (int bj = 0; bj < 2; ++bj) { const f32x4 v0 = acc[ai][bj][m][0], v1 = acc[ai][bj][m][1];
                    u32x4 w; w.x = cvt_pk_bf16(v0[0], v0[1]); w.y = cvt_pk_bf16(v0[2], v0[3]); w.z = cvt_pk_bf16(v1[0], v1[1]); w.w = cvt_pk_bf16(v1[2], v1[3]);
                    *(u32x4*)(rowp + bj * HALF) = w; } }
    }
};
struct EpiResid {
    static constexpr bool PERM = false, AFTER_DRAIN = false;
    const float* src_lat; const float* src_ctx; float* dst_lat; float* dst_ctx; const float* gate;
    __device__ __forceinline__ void operator()(const f32x4 (&acc)[2][2][4][2], const Unit& u, int wr, int wc, int fr, int fq) const {
        const int row0 = u.pm * BM + wr * 64 + fr, col0 = u.pn * BM + wc * 32 + 4 * fq;
#pragma unroll
        for (int ai = 0; ai < 2; ++ai)
#pragma unroll
            for (int m = 0; m < 4; ++m) { const int row = row0 + ai * HALF + m * 16; const bool lat = row < NLAT; const size_t ro = lat ? (size_t)row * 1024 : (size_t)(row - NLAT) * 1024;
                const float* s = (lat ? src_lat : src_ctx) + ro + col0; float* d = (lat ? dst_lat : dst_ctx) + ro + col0; const float* g = gate + (lat ? (row >> 14) : 2) * 6144 + col0;
#pragma unroll
                for (int bj = 0; bj < 2; ++bj)
#pragma unroll
                    for (int n = 0; n < 2; ++n) { const int o = bj * HALF + n * 16; *(f32x4*)(d + o) = *(const f32x4*)(s + o) + *(const f32x4*)(g + o) * acc[ai][bj][m][n]; } }
    }
};
struct EpiSwiglu {
    static constexpr bool PERM = true, AFTER_DRAIN = false; bf16_t* act; int ldc; int row_off;
    __device__ __forceinline__ void operator()(const f32x4 (&acc)[2][2][4][2], const Unit& u, int wr, int wc, int fr, int fq) const {
        const int row0 = u.pm * BM - row_off + wr * 64 + fr, col0 = u.pn * HALF + wc * 32 + 8 * fq;
#pragma unroll
        for (int ai = 0; ai < 2; ++ai)
#pragma unroll
            for (int m = 0; m < 4; ++m) { bf16_t* rowp = act + (size_t)(row0 + ai * HALF + m * 16) * ldc + col0;
                float o[8];
#pragma unroll
                for (int n = 0; n < 2; ++n)
#pragma unroll
                    for (int i = 0; i < 4; ++i) { const float x = acc[ai][0][m][n][i], y = acc[ai][1][m][n][i]; o[4 * n + i] = x / (1.0f + __expf(-x)) * y; }
                u32x4 w; w.x = cvt_pk_bf16(o[0], o[1]); w.y = cvt_pk_bf16(o[2], o[3]); w.z = cvt_pk_bf16(o[4], o[5]); w.w = cvt_pk_bf16(o[6], o[7]);
                *(u32x4*)rowp = w; }
    }
};
struct EpiBf16Out {
    static constexpr bool PERM = true, AFTER_DRAIN = false; bf16_t* O; int ldc;
    __device__ __forceinline__ void operator()(const f32x4 (&acc)[2][2][4][2], const Unit& u, int wr, int wc, int fr, int fq) const {
        const int row0 = u.pm * BM + wr * 64 + fr, col0 = u.pn * BM + wc * 32 + 8 * fq;
#pragma unroll
        for (int ai = 0; ai < 2; ++ai)
#pragma unroll
            for (int m = 0; m < 4; ++m) { bf16_t* rowp = O + (size_t)(row0 + ai * HALF + m * 16) * ldc + col0;
#pragma unroll
                for (int bj = 0; bj < 2; ++bj) { const f32x4 v0 = acc[ai][bj][m][0], v1 = acc[ai][bj][m][1];
                    u32x4 w; w.x = cvt_pk_bf16(v0[0], v0[1]); w.y = cvt_pk_bf16(v0[2], v0[3]); w.z = cvt_pk_bf16(v1[0], v1[1]); w.w = cvt_pk_bf16(v1[2], v1[3]);
                    *(u32x4*)(rowp + bj * HALF) = w; } }
    }
};
struct MoeOrder {
    int nM, nN, mb0, G, c; int ps[8]; size_t estride;
    __device__ __forceinline__ bool next(int i, Unit& u) const { const long L = (long)i * G + c; if (L >= (long)nM * nN) return false; u.pm = mb0 + (int)(L % nM); u.pn = (int)(L / nM); return true; }
    __device__ __forceinline__ void a_ready(const Unit&) const {}
    __device__ __forceinline__ void done(const Unit&) const {}
    __device__ __forceinline__ const char* bptr(const Gemm& g, const Unit& u, size_t tstep) const { const int slot = u.pm << 8; int e = 0;
#pragma unroll
        for (int i = 1; i < 8; ++i) e += slot >= ps[i] ? 1 : 0;
        return (const char*)g.Bt + (size_t)e * estride + (size_t)u.pn * tstep; }
};
}

__device__ __forceinline__ void moe_pads(const unsigned char* ws, int (&ps)[9]) {
    const int* cnt = (const int*)(ws + WS_CTL + CTL_CNT); int acc = 0;
#pragma unroll
    for (int e = 0; e < 8; ++e) { ps[e] = acc; const int c = __builtin_amdgcn_readfirstlane(__hip_atomic_load(cnt + e, __ATOMIC_RELAXED, __HIP_MEMORY_SCOPE_AGENT)); acc += (c + 255) / 256 * 256; }
    ps[8] = acc;
}
__device__ __forceinline__ void phase_moe_assign(const Args& a, int gw, int lane) {
    unsigned char* ws = a.ws;
    int ps[9]; moe_pads(ws, ps);
    const int* tok_e = (const int*)(ws + WS_TOK); const float* tok_w = (const float*)(ws + WS_TOK + 262144); int* tok_slot = (int*)(ws + WS_TOK + 524288);
    int* slot_tok = (int*)(ws + WS_SLOT); float* slot_w = (float*)(ws + WS_SLOT + 270336);
    const bf16* hb = (const bf16*)(ws + WS_HBUF); bf16* xb = (bf16*)(ws + WS_XB);
    const int row = gw * 16 + (lane & 15), k = (lane >> 4) & 1; const bool act = lane < 32;
    const int e = act ? tok_e[2 * row + k] : -1; int slot = 0;
    int sb[8];
#pragma unroll
    for (int ee = 0; ee < 8; ++ee) sb[ee] = 0;
    { typedef int i32x4 __attribute__((ext_vector_type(4))); const i32x4* wc4 = (const i32x4*)(ws + WS_CTL + 262144);
#pragma unroll 4
        for (int w = lane; w < gw; w += 64) { const i32x4 c0 = wc4[2 * w], c1 = wc4[2 * w + 1];
            sb[0] += c0.x; sb[1] += c0.y; sb[2] += c0.z; sb[3] += c0.w; sb[4] += c1.x; sb[5] += c1.y; sb[6] += c1.z; sb[7] += c1.w; } }
#pragma unroll
    for (int ee = 0; ee < 8; ++ee) {
        const unsigned long long mask = __ballot(e == ee);
        int t = sb[ee];
#pragma unroll
        for (int o = 1; o < 64; o <<= 1) t += __shfl_xor(t, o);
        if (e == ee) slot = ps[ee] + t + __popcll(mask & ((1ull << lane) - 1ull));
    }
    if (act) { slot_tok[slot] = row; slot_w[slot] = tok_w[2 * row + k]; tok_slot[2 * row + k] = slot; }
#pragma unroll 4
    for (int i = 0; i < 32; ++i) { const int r = __shfl(row, i), s = __shfl(slot, i);
        const u32x4* src = (const u32x4*)(hb + (size_t)r * 1024); u32x4* dst = (u32x4*)(xb + (size_t)s * 1024);
        dst[lane] = src[lane]; dst[lane + 64] = src[lane + 64]; }
}
struct TrDesc { const float* src; bf16* dst; int ldn, ldk; };
__device__ __forceinline__ TrDesc moe_tr_desc(const Args& a, int it) {
    constexpr int I_W1 = 16 * 56, I_W2 = 56 * 16, PER_E = 2 * I_W1 + I_W2; unsigned char* ws = a.ws;
    const int e = it / PER_E; int r = it % PER_E; TrDesc d;
    if (r < 2 * I_W1) { const int which = r / I_W1, q = r % I_W1, kb = q / 56, nb = q % 56;
        d.src = a.in[which ? 23 : 22] + (size_t)e * 1024 * DFFE + (size_t)(64 * kb) * DFFE + 64 * nb; d.ldn = DFFE;
        d.dst = (bf16*)(ws + WS_MW13) + ((size_t)e * 7168 + w13_row(64 * nb) + 128 * which) * 1024 + 64 * kb; d.ldk = 1024; }
    else { r -= 2 * I_W1; const int kb = r / 16, nb = r % 16;
        d.src = a.in[24] + (size_t)e * DFFE * 1024 + (size_t)(64 * kb) * 1024 + 64 * nb; d.ldn = 1024;
        d.dst = (bf16*)(ws + WS_MW2) + ((size_t)e * 1024 + 64 * nb) * DFFE + 64 * kb; d.ldk = DFFE; }
    return d;
}
__device__ __forceinline__ void phase_moe_convert(const Args& a, LAS unsigned char* lds, int gw, int ngw, int wave, int lane) {
    LAS float* scr = (LAS float*)(lds + wave * 16640);
    constexpr int NIT = 8 * (2 * 16 * 56 + 56 * 16);
    const int r = lane >> 4, c4 = lane & 15, c = lane & 7;
    if (gw >= NIT) return;
    TrDesc cur = moe_tr_desc(a, gw);
    f32x4 v[16];
#pragma unroll
    for (int i = 0; i < 16; ++i) v[i] = __builtin_nontemporal_load((const f32x4*)(cur.src + (size_t)(4 * i + r) * cur.ldn + 4 * c4));
#pragma unroll 1
    for (int it = gw; it < NIT; it += ngw) {
        const bool more = it + ngw < NIT; TrDesc nxt = more ? moe_tr_desc(a, it + ngw) : cur;
        f32x4 nv[16];
#pragma unroll
        for (int i = 0; i < 16; ++i) nv[i] = __builtin_nontemporal_load((const f32x4*)(nxt.src + (size_t)(4 * i + r) * nxt.ldn + 4 * c4));
#pragma unroll
        for (int i = 0; i < 16; ++i) { LAS float* d = scr + (4 * i + r) * 65 + 4 * c4; d[0] = v[i][0]; d[1] = v[i][1]; d[2] = v[i][2]; d[3] = v[i][3]; }
        LDS_WAIT();
#pragma unroll
        for (int j = 0; j < 8; ++j) { const int n = (lane >> 3) + 8 * j; const LAS float* s = scr + (8 * c) * 65 + n;
            u32x4 o; o.x = pk2(s[0 * 65], s[1 * 65]); o.y = pk2(s[2 * 65], s[3 * 65]); o.z = pk2(s[4 * 65], s[5 * 65]); o.w = pk2(s[6 * 65], s[7 * 65]);
            __builtin_nontemporal_store(o, (u32x4*)(cur.dst + (size_t)n * cur.ldk + 8 * c)); }
        LDS_WAIT();
#pragma unroll
        for (int i = 0; i < 16; ++i) v[i] = nv[i];
        cur = nxt;
    }
}
__device__ __forceinline__ void phase_moe_combine(const Args& a, int gw, int ngw, int lane) {
    unsigned char* ws = a.ws;
    const float* tok_w = (const float*)(ws + WS_TOK + 262144); const int* tok_slot = (const int*)(ws + WS_TOK + 524288);
    const bf16* y = (const bf16*)(ws + WS_XB);
    const float* gate = (const float*)(ws + WS_CTL + CTL_MODV) + (size_t)3 * 6144 + 5120;
    auto ld_idx = [&](int row, int& s0, int& s1, float& w0, float& w1) { const int r = row < NLAT ? row : gw; s0 = tok_slot[2 * r]; s1 = tok_slot[2 * r + 1]; w0 = tok_w[2 * r]; w1 = tok_w[2 * r + 1]; };
    int s0c, s1c, s0n, s1n; float w0c, w1c, w0n, w1n;
    ld_idx(gw, s0c, s1c, w0c, w1c); ld_idx(gw + ngw, s0n, s1n, w0n, w1n);
    f32x4 xc[4]; u32x2 yac[4], ybc[4];
    { const float* xr0 = a.out + (size_t)gw * 1024;
#pragma unroll
        for (int j = 0; j < 4; ++j) { const int k = 4 * lane + 256 * j; xc[j] = *(const f32x4*)(xr0 + k); yac[j] = *(const u32x2*)(y + (size_t)s0c * 1024 + k); ybc[j] = *(const u32x2*)(y + (size_t)s1c * 1024 + k); } }
    for (int row = gw; row < NLAT; row += ngw) {
        int s0f, s1f; float w0f, w1f; ld_idx(row + 2 * ngw, s0f, s1f, w0f, w1f);
        f32x4 xn[4]; u32x2 yan[4], ybn[4];
        { const int rn = row + ngw < NLAT ? row + ngw : row; const float* xr2 = a.out + (size_t)rn * 1024;
#pragma unroll
            for (int j = 0; j < 4; ++j) { const int k = 4 * lane + 256 * j; xn[j] = *(const f32x4*)(xr2 + k); yan[j] = *(const u32x2*)(y + (size_t)s0n * 1024 + k); ybn[j] = *(const u32x2*)(y + (size_t)s1n * 1024 + k); } }
        float* xr = a.out + (size_t)row * 1024; const float* g = gate + (row >> 14) * 6144; const float w0 = w0c, w1 = w1c;
#pragma unroll
        for (int j = 0; j < 4; ++j) { const int k = 4 * lane + 256 * j; const u32x2 ya = yac[j], yb = ybc[j];
            f32x4 m; m[0] = w0 * bflo(ya.x) + w1 * bflo(yb.x); m[1] = w0 * bfhi(ya.x) + w1 * bfhi(yb.x); m[2] = w0 * bflo(ya.y) + w1 * bflo(yb.y); m[3] = w0 * bfhi(ya.y) + w1 * bfhi(yb.y);
            *(f32x4*)(xr + k) = xc[j] + *(const f32x4*)(g + k) * m; }
#pragma unroll
        for (int j = 0; j < 4; ++j) { xc[j] = xn[j]; yac[j] = yan[j]; ybc[j] = ybn[j]; }
        s0c = s0n; s1c = s1n; w0c = w0n; w1c = w1n; s0n = s0f; s1n = s1f; w0n = w0f; w1n = w1f;
    }
}
constexpr int PQ = 0, PK = 17408, PV = 34816, PKK = 52224, PAS = 85504, PTS = 118272, PGC = 136704;
__device__ __forceinline__ void dn_prep_item(const Args& a, int l, int item, LAS unsigned char* lds, int tid, int wave, int lane) {
    unsigned char* ws = a.ws;
    const int h = item & 3, cs = (item >> 2) % 260, b = (item >> 2) / 260;
    const int rowbase = cs < 4 ? NLAT + b * CTXL + 64 * cs : b * SEQ + 64 * (cs - 4);
    const int seqlo = cs < 4 ? NLAT + b * CTXL : b * SEQ, seqhi = cs < 4 ? seqlo + CTXL : seqlo + SEQ;
    const bf16* qkv = (const bf16*)(ws + WS_QKV);
    unsigned char* dns = ws + WS_DNS + (size_t)item * DNS_ITEM;
    float gpre = 0.f, bpre = 0.f;
    if (wave < 2) { const int tok = wave ? 63 - lane : lane; const float* gb = (const float*)(ws + WS_GAB) + (size_t)(rowbase + tok) * 16; gpre = gb[wave * 4 + h]; bpre = gb[8 + wave * 4 + h]; }
    { LAS float* cwl = (LAS float*)(lds + PAS);
        for (int i = tid; i < 1152; i += 512) { const int sj = i >> 7, c = i & 127, sec = sj / 3, j = sj % 3; cwl[i] = a.in[9][(size_t)l * 3 * 1536 + j * 1536 + sec * 512 + h * 128 + c]; } }
    __syncthreads();
    {
        const int r = tid >> 3, cgp = tid & 7, row = rowbase + r;
        float vals[3][16];
#pragma unroll
        for (int sec = 0; sec < 3; ++sec) {
            const int ch = sec * 512 + h * 128 + cgp * 16;
            const LAS float* cw = (const LAS float*)(lds + PAS) + sec * 384 + cgp * 16;
            float acc[16];
#pragma unroll
            for (int e = 0; e < 16; ++e) acc[e] = 0.f;
            u32x4 P[3][2]; float msk[3];
#pragma unroll
            for (int j = 0; j < 3; ++j) { const int rr = row + j - 1; msk[j] = (rr >= seqlo && rr < seqhi) ? 1.0f : 0.0f; const int rc = min(max(rr, seqlo), seqhi - 1);
                P[j][0] = *(const u32x4*)(qkv + (size_t)rc * 1536 + ch); P[j][1] = *(const u32x4*)(qkv + (size_t)rc * 1536 + ch + 8); }
#pragma unroll
            for (int j = 0; j < 3; ++j) { const u32x4 p0 = P[j][0], p1 = P[j][1]; const float m = msk[j];
                    const unsigned pw[8] = {p0.x, p0.y, p0.z, p0.w, p1.x, p1.y, p1.z, p1.w};
#pragma unroll
                    for (int e = 0; e < 8; ++e) { acc[2 * e] += bflo(pw[e]) * (cw[j * 128 + 2 * e] * m); acc[2 * e + 1] += bfhi(pw[e]) * (cw[j * 128 + 2 * e + 1] * m); } }
#pragma unroll
            for (int e = 0; e < 16; ++e) vals[sec][e] = silu_f(acc[e]);
            __builtin_amdgcn_sched_barrier(0);
        }
#pragma unroll
        for (int sec = 0; sec < 3; ++sec) {
            float sc = 1.0f;
            if (sec < 2) { float ss = 0.f;
#pragma unroll
                for (int e = 0; e < 16; ++e) ss += vals[sec][e] * vals[sec][e];
                ss += __shfl_xor(ss, 1); ss += __shfl_xor(ss, 2); ss += __shfl_xor(ss, 4);
                sc = rsqrtf(ss + EPS); }
            LAS unsigned* dst = (LAS unsigned*)(lds + (sec == 0 ? PQ : sec == 1 ? PK : PV) + r * 272 + cgp * 32);
#pragma unroll
            for (int e = 0; e < 8; ++e) dst[e] = pk2(vals[sec][2 * e] * sc, vals[sec][2 * e + 1] * sc);
        }
    }
    __syncthreads();
    {
#pragma unroll
        for (int i = 0; i < 2; ++i) { const int p = tid + 512 * i, mt = p >> 8, kk = (p >> 6) & 3, ln = p & 63, row = 16 * mt + (ln & 15), g = ln >> 4;
            const LAS unsigned char* src = lds + PQ + row * 272 + (32 * kk + 4 * g) * 2;
            const u32x2 lo = *(const LAS u32x2*)src, hi = *(const LAS u32x2*)(src + 32);
            *(u32x4*)(dns + (size_t)p * 16) = (u32x4){lo.x, lo.y, hi.x, hi.y}; }
        for (int p = tid; p < 1088; p += 512) *(u32x4*)(dns + 16384 + (size_t)p * 16) = *(const LAS u32x4*)(lds + PK + p * 16);
#pragma unroll
        for (int i = 0; i < 4; ++i) { const int p = tid + 512 * i, s = p >> 8, mt = (p >> 6) & 3, ln = p & 63, tok = 16 * mt + 4 * (ln >> 4), dv = 16 * s + (ln & 15);
            const LAS bf16* vs = (const LAS bf16*)(lds + PV);
            *(u32x2*)(dns + 33792 + (size_t)p * 8) = (u32x2){(unsigned)vs[tok * 136 + dv] | ((unsigned)vs[(tok + 1) * 136 + dv] << 16), (unsigned)vs[(tok + 2) * 136 + dv] | ((unsigned)vs[(tok + 3) * 136 + dv] << 16)}; }
    }
    {
#pragma unroll
        for (int t = 0; t < 4; ++t) { const int T = 4 * wave + t, which = T >> 4, ti = (T >> 2) & 3, tj = T & 3; f32x4 acc = {0.f, 0.f, 0.f, 0.f};
#pragma unroll
            for (int kk = 0; kk < 4; ++kk) { const bf16x8 av = *(const LAS bf16x8*)(lds + (which ? PQ : PK) + (16 * ti + (lane & 15)) * 272 + (32 * kk + 8 * (lane >> 4)) * 2);
                const bf16x8 bv = *(const LAS bf16x8*)(lds + PK + (16 * tj + (lane & 15)) * 272 + (32 * kk + 8 * (lane >> 4)) * 2);
                acc = MFMA16(av, bv, acc); }
            LAS float* o = (LAS float*)(lds + PKK) + which * 4160 + (16 * ti + 4 * (lane >> 4)) * 65 + 16 * tj + (lane & 15);
#pragma unroll
            for (int r = 0; r < 4; ++r) o[r * 65] = acc[r]; }
    }
    if (wave < 2) { const int d = wave, tok = d ? 63 - lane : lane;
        float gc = gpre; const float bt = bpre;
#pragma unroll
        for (int o = 1; o < 64; o <<= 1) { const float t = __shfl_up(gc, o); if (lane >= o) gc += t; }
        const float glast = __shfl(gc, 63);
        LAS float* gcs = (LAS float*)(lds + PGC) + d * 128; gcs[tok] = gc; gcs[64 + tok] = bt;
        float* aux = (float*)(ws + WS_DND + (size_t)(item * 2 + d) * DND_ITEM + 16384);
        aux[tok] = bt; aux[64 + tok] = __expf(gc); aux[128 + tok] = __expf(glast - gc); if (lane == 0) aux[192] = __expf(glast); }
    __syncthreads();
    {
        const LAS float* kkm = (const LAS float*)(lds + PKK); const LAS float* qkm = kkm + 4160;
#pragma unroll
        for (int d = 0; d < 2; ++d) { const LAS float* gcs = (const LAS float*)(lds + PGC) + d * 128; LAS float* as = (LAS float*)(lds + PAS) + d * 4096;
            for (int idx = tid; idx < 4096; idx += 512) { const int p = idx >> 6, p2 = idx & 63, i = d ? 63 - p : p, j = d ? 63 - p2 : p2;
                as[idx] = p2 < p ? gcs[64 + i] * kkm[i * 65 + j] * __expf(gcs[i] - gcs[j]) : 0.f; }
            { const int mt = tid >> 7, kk = (tid >> 6) & 1, ln = tid & 63, i = 16 * mt + (ln & 15), g = ln >> 4; float v[8];
#pragma unroll
                for (int e = 0; e < 8; ++e) { const int j = 32 * kk + (e < 4 ? 4 * g + e : 16 + 4 * g + e - 4); const bool ok = d ? (j >= i) : (j <= i);
                    v[e] = ok ? qkm[i * 65 + j] * __expf(gcs[i] - gcs[j]) * 0.08838834764831845f : 0.f; }
                *(u32x4*)(ws + WS_DND + (size_t)(item * 2 + d) * DND_ITEM + 8192 + (size_t)tid * 16) = (u32x4){pk2(v[0], v[1]), pk2(v[2], v[3]), pk2(v[4], v[5]), pk2(v[6], v[7])}; }
        }
    }
    __syncthreads();
    if (wave < 2) { const int d = wave; const LAS float* as = (const LAS float*)(lds + PAS) + d * 4096; float t[64];
        t[0] = (lane == 0) ? 1.0f : 0.0f;
        int ar = __float_as_int(as[64 + lane]);
#pragma unroll
        for (int p = 1; p < 64; ++p) {
            const int an = __float_as_int(as[((p + 1) & 63) * 64 + lane]);
            float acc = (p == lane) ? 1.0f : 0.0f;
#pragma unroll
            for (int p2 = 0; p2 < p; ++p2) acc -= __int_as_float(__builtin_amdgcn_readlane(ar, p2)) * t[p2];
            t[p] = acc; ar = an; }
        LAS bf16* ts = (LAS bf16*)(lds + PTS) + d * 4608; const int jc = d ? 63 - lane : lane;
#pragma unroll
        for (int p = 0; p < 64; ++p) { const int i = d ? 63 - p : p; ts[i * 72 + jc] = f2bf(t[p]); } }
    __syncthreads();
    {
#pragma unroll
        for (int d = 0; d < 2; ++d) { const int mt = tid >> 7, kk = (tid >> 6) & 1, ln = tid & 63, i = 16 * mt + (ln & 15), g = ln >> 4;
            const LAS unsigned char* src = lds + PTS + d * 9216 + i * 144 + (32 * kk + 4 * g) * 2;
            const u32x2 lo = *(const LAS u32x2*)src, hi = *(const LAS u32x2*)(src + 32);
            *(u32x4*)(ws + WS_DND + (size_t)(item * 2 + d) * DND_ITEM + (size_t)tid * 16) = (u32x4){lo.x, lo.y, hi.x, hi.y}; }
    }
    __syncthreads();
}

__device__ __forceinline__ void na_prep_item(const Args& a, int l, int item8, int lane) {
    unsigned char* ws = a.ws; const int item = item8 >> 3, part = item8 & 7;
    const int row = item * 64 + lane;
    bf16* na = (bf16*)(ws + WS_NA) + (size_t)row * 768; bf16* vt = (bf16*)(ws + WS_VT);
    const int b = row < NLAT ? (row >> 14) : ((row - NLAT) >> 8), tpos = row < NLAT ? (row & 16383) : 16384 + ((row - NLAT) & 255);
    const float* qn = a.in[13] + l * 64; const float* kn = a.in[14] + l * 64;
    { const int sec = part >> 2, h = part & 3;
        { u32x4* p = (u32x4*)(na + sec * 256 + h * 64); u32x4 v[8]; float ss = 0.f;
#pragma unroll
            for (int i = 0; i < 8; ++i) { v[i] = p[i]; const unsigned w[4] = {v[i].x, v[i].y, v[i].z, v[i].w};
#pragma unroll
                for (int e = 0; e < 4; ++e) { const float x = bflo(w[e]), y = bfhi(w[e]); ss += x * x + y * y; } }
            const float sc = rsqrtf(ss * (1.0f / 64.0f) + EPS); const float* nw = sec == 0 ? qn : kn;
#pragma unroll
            for (int i = 0; i < 8; ++i) { const unsigned w[4] = {v[i].x, v[i].y, v[i].z, v[i].w}; unsigned o[4];
#pragma unroll
                for (int e = 0; e < 4; ++e) o[e] = pk2(bflo(w[e]) * sc * nw[8 * i + 2 * e], bfhi(w[e]) * sc * nw[8 * i + 2 * e + 1]);
                p[i] = (u32x4){o[0], o[1], o[2], o[3]}; } } }
    if (part < 4) { const int h = part; const u32x4* p = (const u32x4*)(na + 512 + h * 64); bf16* dst = vt + ((size_t)(b * 4 + h) * 64) * 16640 + tpos;
#pragma unroll
        for (int i = 0; i < 8; ++i) { const u32x4 v = p[i]; const unsigned w[4] = {v.x, v.y, v.z, v.w};
#pragma unroll
            for (int e = 0; e < 4; ++e) { dst[(size_t)(8 * i + 2 * e) * 16640] = (bf16)(w[e] & 0xffffu); dst[(size_t)(8 * i + 2 * e + 1) * 16640] = (bf16)(w[e] >> 16); } } }
}

__device__ __forceinline__ void ft_stage1_item(const Args& a, int item, LAS unsigned char* lds, int tid, int wave, int lane) {
    unsigned char* ws = a.ws; const int b = item >> 7, t0 = item & 127;
    const bf16* ft = (const bf16*)(ws + WS_FT);
#pragma unroll
    for (int i = 0; i < 8; ++i) { const int p = tid + 512 * i, t1 = p >> 5, cp = p & 31;
        *(LAS u32x4*)(lds + t1 * 528 + cp * 16) = *(const u32x4*)(ft + (size_t)(b * SEQ + 128 * t1 + t0) * 256 + cp * 8); }
    __syncthreads();
    const int fr = lane & 15, g = lane >> 4, q = fr >> 2, pp = fr & 3;
    const bf16* f1 = (const bf16*)(ws + WS_F1);
    bf16x8 af[2][4];
#pragma unroll
    for (int c = 0; c < 2; ++c)
#pragma unroll
        for (int kk = 0; kk < 4; ++kk) af[c][kk] = *(const bf16x8*)(f1 + (size_t)(c * 128 + 16 * wave + fr) * 128 + 32 * kk + 8 * g);
    const f32x2* tw = (const f32x2*)(ws + WS_TWID); f32x2 twv[4];
#pragma unroll
    for (int r = 0; r < 4; ++r) twv[r] = tw[((16 * wave + 4 * g + r) * t0) & 16383];
    bf16* yb = (bf16*)(ws + WS_Y);
    const unsigned lbase = (unsigned)(size_t)(lds) + (8 * g + q) * 528 + 8 * pp;
#pragma unroll 2
    for (int nt = 0; nt < 16; ++nt) { f32x4 yr = {0.f, 0.f, 0.f, 0.f}, yi = {0.f, 0.f, 0.f, 0.f};
        u32x2 t[8];
#pragma unroll
        for (int kk = 0; kk < 4; ++kk) { const unsigned ad = lbase + 32 * kk * 528 + 32 * nt; t[2 * kk] = tr_issue(ad); t[2 * kk + 1] = tr_issue(ad + 4 * 528); }
        tr_wait8(t[0], t[1], t[2], t[3], t[4], t[5], t[6], t[7]);
#pragma unroll
        for (int kk = 0; kk < 4; ++kk) { const bf16x8 bv = mk8(t[2 * kk].x, t[2 * kk].y, t[2 * kk + 1].x, t[2 * kk + 1].y);
            yr = MFMA16(af[0][kk], bv, yr); yi = MFMA16(af[1][kk], bv, yi); }
#pragma unroll
        for (int r = 0; r < 4; ++r) { const int kb = 16 * wave + 4 * g + r; const float cs = twv[r][0], sn = twv[r][1];
            const float pr = yr[r] * cs + yi[r] * sn, pi = yi[r] * cs - yr[r] * sn;
            const size_t o = ((((size_t)b * 128 + kb) * 2) * 128 + t0) * 256 + 16 * nt + fr;
            yb[o] = f2bf(pr); yb[o + 128 * 256] = f2bf(pi); } }
    __syncthreads();
}
constexpr int SC_Q = 0, SC_K = 16384, SC_T = 33792, SC_QK = 41984, SC_AUX = 50176, SC_BUF = 51200, SC_RPB = 0;
__device__ __forceinline__ void scan_issue(const unsigned char* ws, int item, int d, LAS unsigned char* buf, int wave, int lane) {
    const unsigned char* gs = ws + WS_DNS + (size_t)item * DNS_ITEM + lane * 16;
    const unsigned char* gd = ws + WS_DND + (size_t)(item * 2 + d) * DND_ITEM + lane * 16;
#pragma unroll 1
    for (int i = wave - 2; i < 50; i += 6) { const unsigned char* src = i < 33 ? gs + i * 1024 : gd + (i - 33) * 1024;
        __builtin_amdgcn_global_load_lds((const unsigned*)src, (LAS unsigned*)(buf + i * 1024), 16, 0, 0); }
}
__device__ __forceinline__ void scan_block(const Args& a, int chain, int sg, LAS unsigned char* lds, int wave, int lane) {
    const unsigned char* ws = a.ws;
    const int h = chain & 3, d = (chain >> 2) & 1, b = chain >> 3, fr = lane & 15, g = lane >> 4, s = 2 * sg + (wave & 1);
    bf16* obuf = (bf16*)(ws + WS_HBUF) + (size_t)d * NROW * 512;
    f32x4 S[8];
#pragma unroll
    for (int i = 0; i < 8; ++i) S[i] = (f32x4){0.f, 0.f, 0.f, 0.f};
    auto item_of = [&](int step) { const int cs = step < 4 ? (d ? 3 - step : step) : 4 + (d ? 259 - step : step - 4); return ((b * 260 + cs) << 2) + h; };
    auto load_v = [&](int step, u32x2 (&vv)[4]) { const unsigned char* gv = ws + WS_DNS + (size_t)item_of(step) * DNS_ITEM + 33792 + s * 2048 + lane * 8;
#pragma unroll
        for (int mt = 0; mt < 4; ++mt) vv[mt] = *(const u32x2*)(gv + mt * 512); };
    u32x2 vcur[4], vnxt[4];
#pragma unroll
    for (int mt = 0; mt < 4; ++mt) { vcur[mt] = (u32x2){0u, 0u}; vnxt[mt] = (u32x2){0u, 0u}; }
    if (wave >= 2) { scan_issue(ws, item_of(0), d, lds, wave, lane); scan_issue(ws, item_of(1), d, lds + SC_BUF, wave, lane); }
    if (wave < 2) load_v(0, vcur);
    VM_WAIT(); __builtin_amdgcn_s_barrier(); asm volatile("" ::: "memory");
    int bsel = 0;
#pragma unroll 1
    for (int step = 0; step < 260; ++step) {
        const int b2 = bsel >= 1 ? bsel - 1 : 2;
        if (wave >= 2 && step + 2 < 260) scan_issue(ws, item_of(step + 2), d, lds + b2 * SC_BUF, wave, lane);
        if (wave < 2) {
        if (step + 1 < 260) load_v(step + 1, vnxt);
        LAS unsigned char* bf = lds + bsel * SC_BUF;
        const unsigned ktbase = (unsigned)(size_t)bf + SC_K + (4 * g + (fr >> 2)) * 272 + 8 * (fr & 3);
        const int cs = step < 4 ? (d ? 3 - step : step) : 4 + (d ? 259 - step : step - 4);
        const int rowbase = cs < 4 ? NLAT + b * CTXL + 64 * cs : b * SEQ + 64 * (cs - 4);
        bf16x8 Sb[4];
#pragma unroll
        for (int kk = 0; kk < 4; ++kk) Sb[kk] = pack8(S[2 * kk], S[2 * kk + 1]);
        bf16x8 KF[4][4], QF[4][4];
#pragma unroll
        for (int mt = 0; mt < 4; ++mt)
#pragma unroll
            for (int kk = 0; kk < 4; ++kk) { const LAS unsigned char* kp = bf + SC_K + (16 * mt + fr) * 272 + (32 * kk + 4 * g) * 2; const u32x2 klo = *(const LAS u32x2*)kp, khi = *(const LAS u32x2*)(kp + 32);
                KF[mt][kk] = mk8(klo.x, klo.y, khi.x, khi.y); QF[mt][kk] = *(const LAS bf16x8*)(bf + SC_Q + ((mt * 4 + kk) * 64 + lane) * 16); }
        LDS_WAIT();
        f32x4 KS[4], QS[4];
#pragma unroll
        for (int mt = 0; mt < 4; ++mt) { KS[mt] = (f32x4){0.f, 0.f, 0.f, 0.f}; QS[mt] = (f32x4){0.f, 0.f, 0.f, 0.f};
#pragma unroll
            for (int kk = 0; kk < 4; ++kk) { KS[mt] = MFMA16(KF[mt][kk], Sb[kk], KS[mt]); QS[mt] = MFMA16(QF[mt][kk], Sb[kk], QS[mt]); } }
        bf16x8 TF[4][2], GF[4][2]; f32x4 egc[4], ekd[4], bt4[4];
#pragma unroll
        for (int mt = 0; mt < 4; ++mt) { const int to = (16 * mt + 4 * g) * 4;
            bt4[mt] = *(const LAS f32x4*)(bf + SC_AUX + to); egc[mt] = *(const LAS f32x4*)(bf + SC_AUX + 256 + to); ekd[mt] = *(const LAS f32x4*)(bf + SC_AUX + 512 + to);
#pragma unroll
            for (int k2 = 0; k2 < 2; ++k2) { TF[mt][k2] = *(const LAS bf16x8*)(bf + SC_T + ((mt * 2 + k2) * 64 + lane) * 16); GF[mt][k2] = *(const LAS bf16x8*)(bf + SC_QK + ((mt * 2 + k2) * 64 + lane) * 16); } }
        const float egl = *(const LAS float*)(bf + SC_AUX + 768);
        LDS_WAIT();
        f32x4 D[4];
#pragma unroll
        for (int mt = 0; mt < 4; ++mt) { const u32x2 vv = vcur[mt]; const f32x4 v4 = {bflo(vv.x), bfhi(vv.x), bflo(vv.y), bfhi(vv.y)}; D[mt] = bt4[mt] * (v4 - egc[mt] * KS[mt]); }
        bf16x8 Db[2];
#pragma unroll
        for (int k2 = 0; k2 < 2; ++k2) Db[k2] = pack8(D[2 * k2], D[2 * k2 + 1]);
        f32x4 VN[4];
#pragma unroll
        for (int mt = 0; mt < 4; ++mt) { VN[mt] = (f32x4){0.f, 0.f, 0.f, 0.f};
#pragma unroll
            for (int k2 = 0; k2 < 2; ++k2) VN[mt] = MFMA16(TF[mt][k2], Db[k2], VN[mt]); }
        bf16x8 Vb[2], Vd[2];
#pragma unroll
        for (int k2 = 0; k2 < 2; ++k2) { Vb[k2] = pack8(VN[2 * k2], VN[2 * k2 + 1]); Vd[k2] = pack8(ekd[2 * k2] * VN[2 * k2], ekd[2 * k2 + 1] * VN[2 * k2 + 1]); }
        u32x2 t[32];
#pragma unroll
        for (int dt = 0; dt < 8; ++dt)
#pragma unroll
            for (int k2 = 0; k2 < 2; ++k2) { const unsigned ad = ktbase + (32 * k2) * 272 + (16 * dt) * 2; t[(dt * 2 + k2) * 2] = tr_issue(ad); t[(dt * 2 + k2) * 2 + 1] = tr_issue(ad + 16 * 272); }
#pragma unroll
        for (int mt = 0; mt < 4; ++mt) { f32x4 O = egc[mt] * QS[mt] * 0.08838834764831845f;
#pragma unroll
            for (int k2 = 0; k2 < 2; ++k2) O = MFMA16(GF[mt][k2], Vb[k2], O);
            bf16* op = obuf + (size_t)(rowbase + 16 * mt + 4 * g) * 512 + h * 128 + 16 * s + fr;
#pragma unroll
            for (int r = 0; r < 4; ++r) op[r * 512] = f2bf(O[r]); }
        tr_wait8(t[0], t[1], t[2], t[3], t[4], t[5], t[6], t[7]); tr_wait8(t[8], t[9], t[10], t[11], t[12], t[13], t[14], t[15]);
        tr_wait8(t[16], t[17], t[18], t[19], t[20], t[21], t[22], t[23]); tr_wait8(t[24], t[25], t[26], t[27], t[28], t[29], t[30], t[31]);
#pragma unroll
        for (int dt = 0; dt < 8; ++dt) { f32x4 acc = S[dt] * egl;
#pragma unroll
            for (int k2 = 0; k2 < 2; ++k2) acc = MFMA16(mk8(t[(dt * 2 + k2) * 2].x, t[(dt * 2 + k2) * 2].y, t[(dt * 2 + k2) * 2 + 1].x, t[(dt * 2 + k2) * 2 + 1].y), Vd[k2], acc);
            S[dt] = acc; }
#pragma unroll
        for (int mt = 0; mt < 4; ++mt) vcur[mt] = vnxt[mt];
        }
        if (wave >= 2) { if (step + 2 < 260) { if (wave < 4) asm volatile("s_waitcnt vmcnt(9)" ::: "memory"); else asm volatile("s_waitcnt vmcnt(8)" ::: "memory"); } else VM_WAIT(); }
        LDS_WAIT(); __builtin_amdgcn_s_barrier(); asm volatile("" ::: "memory");
        bsel = bsel == 2 ? 0 : bsel + 1;
    }
}

template <bool CTXQ> __device__ __forceinline__ void na_wave(const Args& a, int item, LAS unsigned char* lds, int lane) {
    const unsigned char* ws = a.ws; const int fr = lane & 15, g = lane >> 4;
    const bf16* na = (const bf16*)(ws + WS_NA); const bf16* vt = (const bf16*)(ws + WS_VT); bf16* mix = (bf16*)(ws + WS_QKV);
    int b, h, r = 0, wq = 0, qrow, r0 = 0, cw0 = 0;
    if (CTXQ) { const int qb = item & 15; h = (item >> 4) & 3; b = item >> 6; qrow = NLAT + b * CTXL + 16 * qb + fr; }
    else { wq = item & 3; r = (item >> 2) & 255; h = (item >> 10) & 3; b = item >> 12; qrow = b * SEQ + 64 * r + 16 * wq + fr;
        r0 = min(max(r - 4, 0), 248); cw0 = min(max(16 * wq - 8, 0), 32); }
    bf16x8 qf[2];
#pragma unroll
    for (int kk = 0; kk < 2; ++kk) qf[kk] = *(const bf16x8*)(na + (size_t)qrow * 768 + h * 64 + 32 * kk + 8 * g);
    constexpr int NT = CTXQ ? 16 : 32, T0 = CTXQ ? 16 : 0;
    f32x4 sc[NT];
#pragma unroll
    for (int t = 0; t < NT; ++t) { const int T = T0 + t;
        const int krow = T < 16 ? b * SEQ + (r0 + (T >> 1)) * 64 + cw0 + 16 * (T & 1) + fr : NLAT + b * CTXL + 16 * (T - 16) + fr;
        f32x4 acc = {0.f, 0.f, 0.f, 0.f};
#pragma unroll
        for (int kk = 0; kk < 2; ++kk) acc = MFMA16(*(const bf16x8*)(na + (size_t)krow * 768 + 256 + h * 64 + 32 * kk + 8 * g), qf[kk], acc);
        sc[t] = acc * (0.125f * LOG2E); if ((t & 3) == 3) __builtin_amdgcn_sched_barrier(0); }
    float mx = -3.0e38f;
    if (!CTXQ) { const LAS float* rpb = (const LAS float*)(lds + SC_RPB) + h * 465; const int qcol = 16 * wq + fr, c0 = min(max(qcol - 8, 0), 48);
#pragma unroll
        for (int t = 0; t < 16; ++t) { const int offr = r0 + (t >> 1) - r + 7;
#pragma unroll
            for (int j = 0; j < 4; ++j) { const int kc = cw0 + 16 * (t & 1) + 4 * g + j; const bool ok = kc >= c0 && kc < c0 + 16; const int offc = min(max(kc - qcol + 15, 0), 30);
                sc[t][j] = ok ? sc[t][j] + rpb[offr * 31 + offc] : -3.0e38f; } } }
#pragma unroll
    for (int t = 0; t < NT; ++t) mx = fmaxf(fmaxf(fmaxf(sc[t][0], sc[t][1]), fmaxf(sc[t][2], sc[t][3])), mx);
    mx = fmaxf(mx, __shfl_xor(mx, 16)); mx = fmaxf(mx, __shfl_xor(mx, 32));
    float sum = 0.f;
#pragma unroll
    for (int t = 0; t < NT; ++t)
#pragma unroll
        for (int j = 0; j < 4; ++j) { const float p = exp2f(sc[t][j] - mx); sc[t][j] = p; sum += p; }
    sum += __shfl_xor(sum, 16); sum += __shfl_xor(sum, 32);
    const float inv = 1.0f / sum;
    f32x4 O[4];
#pragma unroll
    for (int mt = 0; mt < 4; ++mt) O[mt] = (f32x4){0.f, 0.f, 0.f, 0.f};
    const bf16* vbase = vt + ((size_t)(b * 4 + h) * 64 + fr) * 16640;
#pragma unroll
    for (int k2 = 0; k2 < NT / 2; ++k2) { const int T = T0 + 2 * k2;
        const int tp = T < 16 ? (r0 + (T >> 1)) * 64 + cw0 + 4 * g : 16384 + 16 * (T - 16) + 4 * g;
        const bf16x8 pb = pack8(sc[2 * k2] * inv, sc[2 * k2 + 1] * inv);
#pragma unroll
        for (int mt = 0; mt < 4; ++mt) { const bf16* vp = vbase + (size_t)(16 * mt) * 16640 + tp; const u32x2 lo = *(const u32x2*)vp, hi = *(const u32x2*)(vp + 16);
            O[mt] = MFMA16(mk8(lo.x, lo.y, hi.x, hi.y), pb, O[mt]); } if ((k2 & 1) == 1) __builtin_amdgcn_sched_barrier(0); }
#pragma unroll
    for (int mt = 0; mt < 4; ++mt) { const f32x4 o = O[mt];
        *(u32x2*)(mix + (size_t)qrow * 1024 + 512 + h * 64 + 16 * mt + 4 * g) = (u32x2){pk2(o[0], o[1]), pk2(o[2], o[3])}; }
}
__device__ __forceinline__ void dn_combine(const Args& a, int l, int gw, int ngw, int lane) {
    unsigned char* ws = a.ws; const int nrow = l == 0 ? NROW : NLAT;
    const bf16* of = (const bf16*)(ws + WS_HBUF); const bf16* ob = of + (size_t)NROW * 512; const bf16* zb = (const bf16*)(ws + WS_Z); bf16* mix = (bf16*)(ws + WS_QKV);
    const float* nw = a.in[12] + l * 128 + (8 * lane & 127);
    float w[8];
#pragma unroll
    for (int e = 0; e < 8; ++e) w[e] = nw[e];
    for (int row = gw; row < nrow; row += ngw) {
        const u32x4 pf = *(const u32x4*)(of + (size_t)row * 512 + 8 * lane), pb = *(const u32x4*)(ob + (size_t)row * 512 + 8 * lane), pz = *(const u32x4*)(zb + (size_t)row * 512 + 8 * lane);
        const unsigned f[4] = {pf.x, pf.y, pf.z, pf.w}, bb[4] = {pb.x, pb.y, pb.z, pb.w}, zz[4] = {pz.x, pz.y, pz.z, pz.w};
        float o[8], ss = 0.f;
#pragma unroll
        for (int e = 0; e < 4; ++e) { o[2 * e] = bflo(f[e]) + bflo(bb[e]); o[2 * e + 1] = bfhi(f[e]) + bfhi(bb[e]); ss += o[2 * e] * o[2 * e] + o[2 * e + 1] * o[2 * e + 1]; }
        ss += __shfl_xor(ss, 1); ss += __shfl_xor(ss, 2); ss += __shfl_xor(ss, 4); ss += __shfl_xor(ss, 8);
        const float rinv = rsqrtf(ss * (1.0f / 128.0f) + EPS);
        unsigned ow[4];
#pragma unroll
        for (int e = 0; e < 4; ++e) ow[e] = pk2(o[2 * e] * rinv * w[2 * e] * silu_f(bflo(zz[e])), o[2 * e + 1] * rinv * w[2 * e + 1] * silu_f(bfhi(zz[e])));
        *(u32x4*)(mix + (size_t)row * 1024 + 8 * lane) = (u32x4){ow[0], ow[1], ow[2], ow[3]};
    }
}
__device__ __forceinline__ void ft_stage2_item(const Args& a, int l, int item, LAS unsigned char* lds, int tid, int wave, int lane) {
    unsigned char* ws = a.ws; const bool isctx = item >= 256; int b, kb;
    const bf16* src; const bf16* amat; float scale; size_t tokbase; int tokstride;
    if (!isctx) { b = item >> 7; kb = item & 127; src = (const bf16*)(ws + WS_Y) + (size_t)(b * 128 + kb) * 65536; amat = (const bf16*)(ws + WS_A2); scale = 1.0f; tokbase = (size_t)b * SEQ + kb; tokstride = 128; }
    else { b = (item - 256) >> 1; kb = (item - 256) & 1; src = (const bf16*)(ws + WS_FT) + (size_t)(NLAT + b * CTXL) * 256; amat = (const bf16*)(ws + WS_A2C) + (size_t)kb * 65536; scale = 8.0f; tokbase = (size_t)NLAT + b * CTXL + 128 * kb; tokstride = 1; }
#pragma unroll
    for (int i = 0; i < 16; ++i) { const int p = tid + 512 * i, row = p >> 5, cp = p & 31; *(LAS u32x4*)(lds + row * 528 + cp * 16) = *(const u32x4*)(src + (size_t)row * 256 + cp * 8); }
    __syncthreads();
    const int fr = lane & 15, g = lane >> 4, q = fr >> 2, pp = fr & 3;
    const unsigned lbase = (unsigned)(size_t)(lds) + (8 * g + q) * 528 + 8 * pp;
    f32x4 Z[16][2];
#pragma unroll
    for (int mt = 0; mt < 16; ++mt) { Z[mt][0] = (f32x4){0.f, 0.f, 0.f, 0.f}; Z[mt][1] = (f32x4){0.f, 0.f, 0.f, 0.f}; }
#pragma unroll 1
    for (int kk = 0; kk < 8; ++kk) {
        const bf16x8 b0 = *(const bf16x8*)(amat + (size_t)(16 * wave + fr) * 256 + 32 * kk + 8 * g), b1 = *(const bf16x8*)(amat + (size_t)(128 + 16 * wave + fr) * 256 + 32 * kk + 8 * g);
#pragma unroll
        for (int mt = 0; mt < 16; ++mt) { const unsigned ad = lbase + 32 * kk * 528 + 32 * mt; const bf16x8 av = lds_tr8(ad, ad + 4 * 528);
            Z[mt][0] = MFMA16(av, b0, Z[mt][0]); Z[mt][1] = MFMA16(av, b1, Z[mt][1]); }
    }
    bf16x8 Zb[16];
#pragma unroll
    for (int k3 = 0; k3 < 16; ++k3) { const int c = k3 >> 3, k2 = k3 & 7; Zb[k3] = pack8(Z[2 * k2][c], Z[2 * k2 + 1][c]); }
    const bf16* wft = (const bf16*)(ws + WS_WFT) + (size_t)l * 131072; bf16* mix = (bf16*)(ws + WS_QKV);
    const size_t tok = tokbase + (size_t)(16 * wave + fr) * tokstride;
#pragma unroll 2
    for (int jt = 0; jt < 16; ++jt) { f32x4 acc = {0.f, 0.f, 0.f, 0.f};
#pragma unroll
        for (int k3 = 0; k3 < 16; ++k3) acc = MFMA16(*(const bf16x8*)(wft + ((size_t)(jt * 16 + k3) * 64 + lane) * 8), Zb[k3], acc);
        acc = acc * scale;
        *(u32x2*)(mix + tok * 1024 + 768 + 16 * jt + 4 * g) = (u32x2){pk2(acc[0], acc[1]), pk2(acc[2], acc[3])}; }
    __syncthreads();
}
__global__ __launch_bounds__(512, 2) void mega(Args a0) {
    extern __shared__ __attribute__((aligned(16))) unsigned char shm[];
    cg::grid_group grid = cg::this_grid();
    const int tid0 = threadIdx.x, blk0 = blockIdx.x, nblk = gridDim.x;
#ifndef REP_PH
#define REP_PH (-1)
#endif
    volatile LAS unsigned* xb_st = (volatile LAS unsigned*)((LAS unsigned char*)shm + LDS_BYTES - 16);
    if (tid0 == 0) { xb_st[0] = 0u; xb_st[1] = 0u; }
    __syncthreads();
    const XcdBarrier xb = xcd_barrier_post((unsigned*)(a0.ws + WS_CTL + 524288), xb_st);
    int ph = 0;
#define PH_BEGIN if (ph >= a0.lo && ph < a0.hi) { if (ph > a0.lo) { if (a0.lo < 0) grid.sync(); xcd_barrier(xb); } \
    int tid = tid0, blk = blk0; asm volatile("" : "+v"(tid)); asm volatile("" : "+s"(blk)); \
    Args a = a0; asm volatile("" : "+s"(a.ws)); asm volatile("" : "+s"(a.out)); \
    LAS unsigned char* lds = (LAS unsigned char*)shm; unsigned char* ws = a.ws; const float* modv = (const float*)(ws + WS_CTL + CTL_MODV); \
    const int wave = __builtin_amdgcn_readfirstlane(tid >> 6), lane = tid & 63; \
    const int gw = blk * 8 + wave, ngw = nblk * 8, gtid = blk * 512 + tid, ngt = nblk * 512; (void)gtid; (void)ngt; (void)gw; (void)ngw; (void)modv; (void)lds; (void)lane;
#define PH_END } ++ph;
#ifndef REPP
#define REPP 1
#endif
    PH_BEGIN { for (int rr = 0; rr < REPP; ++rr) phase_prologue(a, lds, gw, ngw, wave, lane, gtid, ngt); } PH_END
#ifdef XSYNC
    for (int xs = 0; xs < XSYNC; ++xs) { asm volatile("s_waitcnt vmcnt(0) lgkmcnt(0)" ::: "memory"); grid.sync(); __builtin_amdgcn_fence(__ATOMIC_ACQUIRE, "agent"); }
#endif
#pragma unroll 1
    for (int l = 0; l < 2; ++l) {
        PH_BEGIN phase_A(a, l, lds, gw, ngw, tid, lane); PH_END
        PH_BEGIN { pg8::Gemm g{(const pg8::bf16_t*)(ws + WS_HBUF), (const pg8::bf16_t*)(ws + WS_WIN) + (size_t)l * 3072 * 1024, NROW, 3072, 1024};
            pg8::StaticOrder S; S.init(NROW, 3072, nblk, blk); pg8::EpiProj E{ws}; pg8::gemm_phase<pg8::EpiProj, pg8::StaticOrder, false>(lds, g, S, E, nullptr); __syncthreads(); } PH_END
        PH_BEGIN {
#ifndef REPC
#define REPC 1
#endif
#pragma unroll 1
            for (int rr = 0; rr < REPC; ++rr)
            for (int it = blk; it < 2080; it += nblk) dn_prep_item(a, l, it, lds, tid, wave, lane);
            if (blk >= 32) { for (int it = (blk - 32) * 8 + wave; it < 4160; it += 1792) na_prep_item(a, l, it, lane);
                for (int it = blk - 32; it < 256; it += 224) ft_stage1_item(a, it, lds, tid, wave, lane); }
        } PH_END
        PH_BEGIN {
            if (blk < 64) scan_block(a, blk & 15, blk >> 4, lds, wave, lane);
            else { LAS float* rpb = (LAS float*)(lds + SC_RPB);
                for (int i = tid; i < 1860; i += 512) rpb[i] = a.in[15][l * 1860 + i] * LOG2E;
                __syncthreads();
                const int nidx = (blk - 64) * 8 + wave;
#pragma unroll 1
                for (int it = nidx; it < 8192 + 128; it += 1536) { if (it < 8192) na_wave<false>(a, it, lds, lane); else if (l == 0) na_wave<true>(a, it - 8192, lds, lane); }
                __syncthreads();
                const int nft = l == 0 ? 260 : 256;
                for (int it = blk - 64; it < nft; it += 192) ft_stage2_item(a, l, it, lds, tid, wave, lane); }
            __syncthreads();
        } PH_END
        PH_BEGIN {
            dn_combine(a, l, gw, ngw, lane);
        } PH_END
        PH_BEGIN { const int M = l == 0 ? NROW : NLAT;
            pg8::Gemm g{(const pg8::bf16_t*)(ws + WS_QKV), (const pg8::bf16_t*)(ws + WS_WOUT) + (size_t)l * 1024 * 1024, M, 1024, 1024};
            pg8::StaticOrder S; S.init(M, 1024, nblk, blk);
            pg8::EpiResid E{l == 0 ? a.in[0] : a.out, l == 0 ? a.in[2] : (const float*)(ws + WS_CTXS), a.out, (float*)(ws + WS_CTXS), modv + (size_t)l * 3 * 6144 + 2048};
            pg8::gemm_phase<pg8::EpiResid, pg8::StaticOrder, false>(lds, g, S, E, nullptr); __syncthreads(); } PH_END
#ifndef REPM
#define REPM 1
#endif
        PH_BEGIN { phase_F(a, l, lds, gw, ngw, tid, lane); if (l == 1) for (int rr = 0; rr < REPM; ++rr) phase_moe_convert(a, lds, gw, ngw, wave, lane); } PH_END
        if (l == 0) {
            PH_BEGIN { pg8::Gemm g{(const pg8::bf16_t*)(ws + WS_HBUF), (const pg8::bf16_t*)(ws + WS_W13), NROW, 5632, 1024};
                pg8::StaticOrder S; S.init(NROW, 5632, nblk, blk); pg8::EpiSwiglu E{(pg8::bf16_t*)(ws + WS_ACT), DFF, 0};
                pg8::gemm_phase<pg8::EpiSwiglu, pg8::StaticOrder, false>(lds, g, S, E, nullptr); __syncthreads(); } PH_END
            PH_BEGIN { pg8::Gemm g{(const pg8::bf16_t*)(ws + WS_ACT), (const pg8::bf16_t*)(ws + WS_W2), NROW, 1024, DFF};
                pg8::StaticOrder S; S.init(NROW, 1024, nblk, blk);
                pg8::EpiResid E{a.out, (const float*)(ws + WS_CTXS), a.out, (float*)(ws + WS_CTXS), modv + 5120};
                pg8::gemm_phase<pg8::EpiResid, pg8::StaticOrder, false>(lds, g, S, E, nullptr); __syncthreads(); } PH_END
        } else {
            PH_BEGIN phase_moe_assign(a, gw, lane); PH_END
            {
                int ps[9]; moe_pads(a0.ws, ps);
                const int nbt = ps[8] >> 8;
#pragma unroll 1
                for (int c0 = 0; c0 < nbt; c0 += MACT_ROWS / 256) {
                    const int nM = nbt - c0 < MACT_ROWS / 256 ? nbt - c0 : MACT_ROWS / 256;
                    PH_BEGIN { pg8::Gemm g{(const pg8::bf16_t*)(ws + WS_XB), (const pg8::bf16_t*)(ws + WS_MW13), 0, 7168, 1024};
                        pg8::MoeOrder S{nM, 28, c0, nblk, blk, {ps[0], ps[1], ps[2], ps[3], ps[4], ps[5], ps[6], ps[7]}, (size_t)7168 * 1024 * 2}; pg8::EpiSwiglu E{(pg8::bf16_t*)(ws + WS_MACT), DFFE, c0 * 256};
                        pg8::gemm_phase<pg8::EpiSwiglu, pg8::MoeOrder, false>(lds, g, S, E, nullptr); __syncthreads(); } PH_END
                    PH_BEGIN { pg8::Gemm g{(const pg8::bf16_t*)(ws + WS_MACT) - (size_t)c0 * 256 * DFFE, (const pg8::bf16_t*)(ws + WS_MW2), 0, 1024, DFFE};
                        pg8::MoeOrder S{nM, 4, c0, nblk, blk, {ps[0], ps[1], ps[2], ps[3], ps[4], ps[5], ps[6], ps[7]}, (size_t)1024 * DFFE * 2}; pg8::EpiBf16Out E{(pg8::bf16_t*)(ws + WS_XB), 1024};
                        pg8::gemm_phase<pg8::EpiBf16Out, pg8::MoeOrder, false>(lds, g, S, E, nullptr); __syncthreads(); } PH_END
                }
            }
            PH_BEGIN phase_moe_combine(a, gw, ngw, lane); PH_END
        }
    }
#ifdef DBG_SRC
    __builtin_amdgcn_fence(__ATOMIC_RELEASE, "agent"); grid.sync(); __builtin_amdgcn_fence(__ATOMIC_ACQUIRE, "agent");
    { const size_t n = (size_t)NLAT * 1024; const size_t gt = (size_t)blk0 * 512 + tid0, ng = (size_t)nblk * 512;
      if (DBG_KIND == 0) { const bf16* src = (const bf16*)(a0.ws + (size_t)DBG_SRC); for (size_t i = gt; i < n; i += ng) { a0.out[i] = (float)(src[i] & 7); } }
      else { const float* src = (const float*)(a0.ws + (size_t)DBG_SRC); for (size_t i = gt; i < n; i += ng) a0.out[i] = src[i % (size_t)DBG_N]; } }
#endif
}
constexpr int N_PHASES = 1 + 9 + 7 + 1 + 16 + 1;
#ifndef DBG_HI
#define DBG_HI (1 << 30)
#endif

extern "C" void kernel_launch(void* const* d_in, const int* in_sizes, int n_in, void* d_out, int out_size, void* d_ws, size_t ws_size, hipStream_t stream) {
    static int inited = 0;
    if (!inited) {
        if (hipFuncSetAttribute((const void*)mega, hipFuncAttributeMaxDynamicSharedMemorySize, LDS_BYTES) != hipSuccess) fprintf(stderr, "kernel_launch: hipFuncSetAttribute failed\n");
        inited = 1;
    }
    (void)hipMemsetAsync((char*)d_ws + WS_CTL, 0, 1048576, stream);
    Args a{};
    for (int i = 0; i < 25; ++i) a.in[i] = (const float*)d_in[i];
    a.out = (float*)d_out; a.ws = (unsigned char*)d_ws; a.lo = 0; a.hi = DBG_HI;
#ifdef MULTI_LAUNCH
    for (int p = 0; p < DBG_HI; p += MULTI_LAUNCH) { a.lo = p; a.hi = p + MULTI_LAUNCH < DBG_HI ? p + MULTI_LAUNCH : DBG_HI;
        void* args[] = {&a};
        hipError_t e = hipLaunchCooperativeKernel((const void*)mega, dim3(256), dim3(512), args, LDS_BYTES, stream);
        if (e != hipSuccess) { fprintf(stderr, "kernel_launch: cooperative launch failed: %s\n", hipGetErrorString(e)); break; } }
#else
    void* args[] = {&a};
    hipError_t e = hipLaunchCooperativeKernel((const void*)mega, dim3(256), dim3(512), args, LDS_BYTES, stream);
    if (e != hipSuccess) fprintf(stderr, "kernel_launch: cooperative launch failed: %s\n", hipGetErrorString(e));
#endif
}
```

```cpp
#include <hip/hip_runtime.h>
#include <hip/hip_cooperative_groups.h>
#include <cstdio>
namespace cg = cooperative_groups;
#define LAS __attribute__((address_space(3)))
typedef unsigned short bf16;
typedef short bf16x8 __attribute__((ext_vector_type(8)));
typedef float f32x4 __attribute__((ext_vector_type(4)));
typedef float f32x2 __attribute__((ext_vector_type(2)));
typedef unsigned u32x4 __attribute__((ext_vector_type(4)));
typedef unsigned u32x2 __attribute__((ext_vector_type(2)));

constexpr int DM = 1024, NLAT = 32768, NCTX = 512, NROW = 33280, SEQ = 16384, CTXL = 256;
constexpr int INW = 3088, DFF = 2816, DFFE = 3584, NEXP = 8;
constexpr float EPS = 1e-6f, LOG2E = 1.4426950408889634f;
constexpr int LDS_BYTES = 155648, NWG_WAVES = 8;

constexpr size_t MB = 1048576;
constexpr size_t WS_CTL = 0;
constexpr size_t CTL_MODV = 0;
constexpr size_t CTL_CNT = 160 * 1024;
constexpr size_t WS_TWID = 1 * MB;
constexpr size_t WS_F1 = WS_TWID + 131072;
constexpr size_t WS_A2 = WS_F1 + 65536;
constexpr size_t WS_A2C = WS_A2 + 131072;
constexpr size_t WS_WFT = WS_A2C + 262144;
constexpr size_t WS_GAB = 3 * MB;
constexpr size_t WS_CTXS = 6 * MB;
constexpr size_t WS_TOK = 8 * MB;
constexpr size_t WS_WIN = 10 * MB;
constexpr size_t WS_WOUT = 22 * MB;
constexpr size_t WS_W13 = 26 * MB;
constexpr size_t WS_W2 = 37 * MB;
constexpr size_t WS_HBUF = 43 * MB;
constexpr size_t WS_QKV = 108 * MB;
constexpr size_t WS_Z = 206 * MB;
constexpr size_t WS_NA = 239 * MB;
constexpr size_t WS_FT = 288 * MB;
constexpr size_t WS_VT = 305 * MB;
constexpr size_t WS_Y = 322 * MB;
constexpr size_t WS_DNS = 354 * MB;
constexpr size_t WS_DND = 484 * MB;
constexpr size_t WS_ACT = WS_DNS;
constexpr size_t WS_MW13 = 108 * MB;
constexpr size_t WS_MW2 = 220 * MB;
constexpr size_t WS_XB = 276 * MB;
constexpr size_t WS_MACT = 408 * MB;
constexpr size_t WS_SLOT = 9 * MB;
constexpr int MACT_ROWS = 16384;
constexpr int DNS_ITEM = 65536, DND_ITEM = 17408;

typedef __bf16 bf16x2_t __attribute__((ext_vector_type(2)));
__device__ __forceinline__ unsigned pk2(float lo, float hi) { bf16x2_t v = {(__bf16)lo, (__bf16)hi}; return __builtin_bit_cast(unsigned, v); }
__device__ __forceinline__ float bflo(unsigned u) { return __uint_as_float(u << 16); }
__device__ __forceinline__ float bfhi(unsigned u) { return __uint_as_float(u & 0xffff0000u); }
__device__ __forceinline__ float bf2f(bf16 b) { return __uint_as_float(((unsigned)b) << 16); }
__device__ __forceinline__ bf16 f2bf(float f) { return (bf16)(pk2(f, 0.f) & 0xffffu); }
__device__ __forceinline__ float wave_sum(float v) {
#pragma unroll
    for (int o = 1; o < 64; o <<= 1) v += __shfl_xor(v, o);
    return v;
}
__device__ __forceinline__ float silu_f(float v) { return v / (1.f + __expf(-v)); }
__device__ __forceinline__ bf16x8 mk8(unsigned a, unsigned b, unsigned c, unsigned d) { u32x4 v = {a, b, c, d}; return __builtin_bit_cast(bf16x8, v); }
__device__ __forceinline__ bf16x8 pack8(f32x4 a, f32x4 b) { return mk8(pk2(a[0], a[1]), pk2(a[2], a[3]), pk2(b[0], b[1]), pk2(b[2], b[3])); }
#define MFMA16(a, b, c) __builtin_amdgcn_mfma_f32_16x16x32_bf16((a), (b), (c), 0, 0, 0)
#define LDS_WAIT() asm volatile("s_waitcnt lgkmcnt(0)" ::: "memory")
#define VM_WAIT() asm volatile("s_waitcnt vmcnt(0)" ::: "memory")
__device__ __forceinline__ bf16x8 lds_tr8(unsigned addr, unsigned addr2) {
    u32x2 a, b;
    asm volatile("ds_read_b64_tr_b16 %0, %2\n\tds_read_b64_tr_b16 %1, %3\n\ts_waitcnt lgkmcnt(0)" : "=&v"(a), "=&v"(b) : "v"(addr), "v"(addr2) : "memory");
    return mk8(a.x, a.y, b.x, b.y);
}

__device__ __forceinline__ u32x2 tr_issue(unsigned addr) { u32x2 r; asm volatile("ds_read_b64_tr_b16 %0, %1" : "=v"(r) : "v"(addr) : "memory"); return r; }
__device__ __forceinline__ void tr_wait8(u32x2& a, u32x2& b, u32x2& c, u32x2& d, u32x2& e, u32x2& f, u32x2& g, u32x2& h) {
    asm volatile("s_waitcnt lgkmcnt(0)" : "+v"(a), "+v"(b), "+v"(c), "+v"(d), "+v"(e), "+v"(f), "+v"(g), "+v"(h) :: "memory"); }

struct Args {
    const float* in[25];
    float* out;
    unsigned char* ws;
    int lo, hi;
};
namespace pg8 {
#define PG8_LAS __attribute__((address_space(3)))
typedef unsigned short bf16_t;
typedef short bf16x8 __attribute__((ext_vector_type(8)));
typedef float f32x4 __attribute__((ext_vector_type(4)));
typedef unsigned u32x4 __attribute__((ext_vector_type(4)));
constexpr int BM = 256, BK = 64, HALF = 128, HTB = HALF * BK * 2  , STAGE_BYTES = 8 * HTB, NXCD = 8, WGM = 8;

__host__ __device__ __forceinline__ int lds_byte(int r, int c) { const int st = (r >> 4) * 2 + (c >> 5), rr = r & 15, cc = c & 31, ob = rr * 64 + cc * 2; return st * 1024 + (ob ^ (((ob >> 9) & 1) << 5)); }
__host__ __device__ __forceinline__ void stage_rc(int b, int& R, int& C) { const int st = b / 1024, sb = b % 1024, swz = sb ^ (((sb >> 9) & 1) << 5); R = (st >> 1) * 16 + swz / 64; C = (st & 1) * 32 + (swz % 64) / 2; }
__host__ __device__ __forceinline__ int perm32(int rho) { const int n = rho >> 4, i = rho & 15; return 8 * (i >> 2) + 4 * n + (i & 3); }

struct Unit { int pm, pn; };
struct Gemm { const bf16_t* A; const bf16_t* Bt; int M, N, K; };

struct StaticOrder {
    int nM, nN, nwg, G, c;
    __host__ __device__ void init(int M, int N, int G_, int c_) { nM = M / BM; nN = N / BM; nwg = nM * nN; G = G_; c = c_; }
    __host__ __device__ bool next(int i, Unit& u) const {
        const long L = (long)i * G + c; if (L >= nwg) return false;
        int wgid = (int)L; { const int q = nwg / NXCD, r = nwg % NXCD, xcd = wgid % NXCD, off = wgid / NXCD; wgid = (xcd < r ? xcd * (q + 1) : r * (q + 1) + (xcd - r) * q) + off; }
        const int nig = WGM * nN, gid = wgid / nig, fm = gid * WGM, gsz = (nM - fm) < WGM ? (nM - fm) : WGM;
        u.pm = fm + ((wgid % nig) % gsz); u.pn = (wgid % nig) / gsz; return true;
    }
    __device__ __forceinline__ void a_ready(const Unit&) const {}
    __device__ __forceinline__ void done(const Unit&) const {}
    __device__ __forceinline__ const char* bptr(const Gemm& g, const Unit& u, size_t tstep) const { return (const char*)g.Bt + (size_t)u.pn * tstep; }
};
__device__ __forceinline__ unsigned cvt_pk_bf16(float lo, float hi) { return pk2(lo, hi); }
template <class Epi, class Sched, bool STAMP = false>
__device__ __forceinline__ void gemm_phase(PG8_LAS unsigned char* lds, const Gemm g, const Sched& S, const Epi& E, unsigned long long* stamps) {
    int tid_l = threadIdx.x; asm volatile("" : "+v"(tid_l)); const int tid = tid_l, wid = __builtin_amdgcn_readfirstlane(tid >> 6), lane = tid & 63, wr = wid >> 2, wc = wid & 3, fr = lane & 15, fq = lane >> 4;
    const int K = g.K, nt = K / BK;
    int ts_lo = 0, ts_hi = 0, nts = 0; const unsigned long long rt_entry = STAMP ? (unsigned long long)wall_clock64() : 0ull;
#define PG8_STAMP() do { if (STAMP && wid == 0 && nts < 64) { const unsigned long long _c = (unsigned long long)clock64(); \
        ts_lo = (lane == nts) ? (int)(unsigned)_c : ts_lo; ts_hi = (lane == nts) ? (int)(unsigned)(_c >> 32) : ts_hi; ++nts; } } while (0)
    PG8_STAMP();
    unsigned voffA[2], voffB[2];
#pragma unroll
    for (int i = 0; i < 2; ++i) { int R, C; stage_rc(tid * 16 + i * 8192, R, C); const int Rb = Epi::PERM ? ((R & ~31) + perm32(R & 31)) : R;
        voffA[i] = (unsigned)(R * K + C) * 2u; voffB[i] = (unsigned)(Rb * K + C) * 2u; }
    const size_t kstep = (size_t)(BK * 2);
    const size_t hstep = (size_t)HALF * K * 2;
    const size_t tstep = 2 * hstep;
    const unsigned ldsw = (unsigned)wid * 1024u;
    const int aoff = lds_byte(wr * 64 + fr, fq * 8), boff = lds_byte(wc * 32 + fr, fq * 8);
#define PG8_SA(b, h) (((b) * 2 + (h)) * HTB)
#define PG8_SB(b, h) ((4 + (b) * 2 + (h)) * HTB)
#define PG8_STAGE(bufoff, gbase, voff) do { _Pragma("unroll") for (int _i = 0; _i < 2; ++_i) \
        __builtin_amdgcn_global_load_lds((const unsigned*)((const char*)(gbase) + (voff)[_i]), (PG8_LAS unsigned*)(lds + (bufoff) + ldsw + _i * 8192), 16, 0, 0); } while (0)
#define PG8_STAGEA(bufoff, gbase, voff) do { _Pragma("unroll") for (int _i = 0; _i < 2; ++_i) \
        __builtin_amdgcn_global_load_lds((const unsigned*)((const char*)(gbase) + (voff)[_i]), (PG8_LAS unsigned*)(lds + (bufoff) + ldsw + _i * 8192), 16, 0, 16); } while (0)
#define PG8_LDA(dst, b, h) do { _Pragma("unroll") for (int m = 0; m < 4; ++m) _Pragma("unroll") for (int k = 0; k < 2; ++k) dst[m][k] = *(const PG8_LAS bf16x8*)(lds + PG8_SA(b, h) + aoff + m * 2048 + k * 1024); } while (0)
#define PG8_LDB(dst, b, h) do { _Pragma("unroll") for (int n = 0; n < 2; ++n) _Pragma("unroll") for (int k = 0; k < 2; ++k) dst[n][k] = *(const PG8_LAS bf16x8*)(lds + PG8_SB(b, h) + boff + n * 2048 + k * 1024); } while (0)
#define PG8_MMA(ai, bj, At, Bt) do { __builtin_amdgcn_s_setprio(1); _Pragma("unroll") for (int m = 0; m < 4; ++m) _Pragma("unroll") for (int n = 0; n < 2; ++n) _Pragma("unroll") for (int k = 0; k < 2; ++k) \
        acc[ai][bj][m][n] = __builtin_amdgcn_mfma_f32_16x16x32_bf16(Bt[n][k], At[m][k], acc[ai][bj][m][n], 0, 0, 0); __builtin_amdgcn_s_setprio(0); } while (0)
#define PG8_WAIT_V(n) asm volatile("s_waitcnt vmcnt(" #n ")" ::: "memory")
#define PG8_WAIT_L(n) asm volatile("s_waitcnt lgkmcnt(" #n ")" ::: "memory")
#define PG8_BAR __builtin_amdgcn_s_barrier()
#define PG8_SCHED __builtin_amdgcn_sched_barrier(0)
    Unit cur, nxt; int ui = 0;
    if (!S.next(0, cur)) return;
    f32x4 acc[2][2][4][2];
#pragma unroll
    for (int a = 0; a < 2; ++a)
#pragma unroll
        for (int b = 0; b < 2; ++b)
#pragma unroll
            for (int m = 0; m < 4; ++m)
#pragma unroll
                for (int n = 0; n < 2; ++n) acc[a][b][m][n] = (f32x4){0.f, 0.f, 0.f, 0.f};
    bf16x8 At[4][2], B0[2][2], B1[2][2];
    const char* cA = (const char*)g.A + (size_t)cur.pm * tstep; const char* cB = S.bptr(g, cur, tstep);
    S.a_ready(cur);
    PG8_STAGE(PG8_SB(0, 0), cB, voffB); PG8_STAGEA(PG8_SA(0, 0), cA, voffA); PG8_STAGE(PG8_SB(0, 1), cB + hstep, voffB); PG8_STAGEA(PG8_SA(0, 1), cA + hstep, voffA);
    if (wr == 1) PG8_BAR;
    PG8_WAIT_V(4); PG8_BAR;
    PG8_STAGE(PG8_SB(1, 0), cB + kstep, voffB); PG8_STAGEA(PG8_SA(1, 0), cA + kstep, voffA); PG8_STAGE(PG8_SB(1, 1), cB + hstep + kstep, voffB);
    PG8_WAIT_V(6); PG8_BAR;
    PG8_STAMP();
    for (;;) {
        const bool has_next = S.next(ui + 1, nxt);
        const char* nA = has_next ? (const char*)g.A + (size_t)nxt.pm * tstep : cA; const char* nB = has_next ? S.bptr(g, nxt, tstep) : cB;
        for (int t = 0; t < nt; t += 2) {
            const bool last = (t == nt - 2);
            const char* a1 = cA + (size_t)(t + 1) * kstep;
            const char* a2 = last ? nA : cA + (size_t)(t + 2) * kstep; const char* b2 = last ? nB : cB + (size_t)(t + 2) * kstep;
            const char* a3 = a2 + kstep; const char* b3 = b2 + kstep;
            if (last && has_next) S.a_ready(nxt);
            PG8_LDB(B0, 0, 0); PG8_SCHED; PG8_LDA(At, 0, 0); PG8_STAGEA(PG8_SA(1, 1), a1 + hstep, voffA);
            PG8_WAIT_L(8); PG8_BAR; PG8_WAIT_L(0); PG8_MMA(0, 0, At, B0); PG8_BAR; PG8_SCHED;
            PG8_LDB(B1, 0, 1); PG8_STAGE(PG8_SB(0, 0), b2, voffB);
            PG8_BAR; PG8_WAIT_L(0); PG8_MMA(0, 1, At, B1); PG8_BAR;
            PG8_LDA(At, 0, 1); PG8_STAGEA(PG8_SA(0, 0), a2, voffA);
            PG8_BAR; PG8_WAIT_L(0); PG8_MMA(1, 0, At, B0); PG8_BAR; PG8_SCHED;
            PG8_STAGE(PG8_SB(0, 1), b2 + hstep, voffB);
            PG8_WAIT_V(6); PG8_BAR; PG8_MMA(1, 1, At, B1); PG8_BAR;
            PG8_LDB(B0, 1, 0); PG8_SCHED; PG8_LDA(At, 1, 0); PG8_STAGEA(PG8_SA(0, 1), a2 + hstep, voffA);
            PG8_WAIT_L(8); PG8_BAR; PG8_WAIT_L(0); PG8_MMA(0, 0, At, B0); PG8_BAR; PG8_SCHED;
            PG8_LDB(B1, 1, 1); PG8_STAGE(PG8_SB(1, 0), b3, voffB);
            PG8_BAR; PG8_WAIT_L(0); PG8_MMA(0, 1, At, B1); PG8_BAR;
            PG8_LDA(At, 1, 1); PG8_STAGEA(PG8_SA(1, 0), a3, voffA);
            PG8_BAR; PG8_WAIT_L(0); PG8_MMA(1, 0, At, B0); PG8_BAR; PG8_SCHED;
            PG8_STAGE(PG8_SB(1, 1), b3 + hstep, voffB);
            PG8_WAIT_V(6); PG8_BAR; PG8_MMA(1, 1, At, B1); PG8_BAR;
        }
        PG8_STAMP();
        if constexpr (!Epi::AFTER_DRAIN) { E(acc, cur, wr, wc, fr, fq); S.done(cur); }
        PG8_STAMP();
        if (!has_next) break;
#pragma unroll
        for (int a = 0; a < 2; ++a)
#pragma unroll
            for (int b = 0; b < 2; ++b)
#pragma unroll
                for (int m = 0; m < 4; ++m)
#pragma unroll
                    for (int n = 0; n < 2; ++n) acc[a][b][m][n] = (f32x4){0.f, 0.f, 0.f, 0.f};
        cur = nxt; cA = nA; cB = nB; ++ui;
    }
    PG8_WAIT_V(0);
    if (wr == 0) PG8_BAR;
    PG8_BAR;
    if constexpr (Epi::AFTER_DRAIN) { E.fused(acc, cur, wr, wc, fr, fq, lds, wid, lane); S.done(cur); }
    PG8_STAMP();
    if (STAMP && wid == 0) { stamps[lane] = lane < nts ? (((unsigned long long)(unsigned)ts_hi << 32) | (unsigned)ts_lo) : 0ull;
        if (lane == 62) stamps[62] = rt_entry; if (lane == 63) stamps[63] = (unsigned long long)wall_clock64(); }
#undef PG8_STAMP
#undef PG8_SA
#undef PG8_SB
#undef PG8_STAGE
#undef PG8_STAGEA
#undef PG8_LDA
#undef PG8_LDB
#undef PG8_MMA
#undef PG8_WAIT_V
#undef PG8_WAIT_L
#undef PG8_BAR
#undef PG8_SCHED
}
}
#define XB_TMO      128
#define XB_XCNT(j)  (256  + 64 * (j))
#define XB_XSUB(j)  (1280 + 64 * (j))
#define XB_XGEN(j)  (2304 + 64 * (j))
#define XB_TOP      3328
#define XB_TOPGEN   3392
#define XCD_BAR_WORDS 3456
#define XB_SPIN_CAP (1u << 18)

__device__ __forceinline__ unsigned xb_ld(unsigned* p)              { return __hip_atomic_load(p, __ATOMIC_RELAXED, __HIP_MEMORY_SCOPE_AGENT); }
__device__ __forceinline__ unsigned xb_add(unsigned* p, unsigned v) { return __hip_atomic_fetch_add(p, v, __ATOMIC_RELAXED, __HIP_MEMORY_SCOPE_AGENT); }
__device__ __forceinline__ unsigned xb_xcc_id() { return (unsigned)__builtin_amdgcn_s_getreg((3 << 11) | 20) & 0xFu; }
#define XB_SPIN(cond, bar) do { unsigned _sp = 0; while (cond) { __builtin_amdgcn_s_sleep(1); \
    if ((++_sp & 255u) == 0u) { if (xb_ld(&(bar)[XB_TMO])) break; if (_sp > XB_SPIN_CAP) { atomicAdd(&(bar)[XB_TMO], 1u); break; } } } } while (0)

struct XcdBarrier {
    unsigned* bar; unsigned x;
    volatile LAS unsigned* st;
};

__device__ __forceinline__ XcdBarrier xcd_barrier_post(unsigned* bar, volatile LAS unsigned* st) {
    XcdBarrier b; b.bar = bar; b.x = xb_xcc_id(); b.st = st;
    if (threadIdx.x == 0) (void)xb_add(&bar[XB_XCNT(b.x)], 1u);
    return b;
}
__device__ __forceinline__ void xcd_barrier_complete(unsigned* bar, unsigned x, unsigned& nloc, unsigned& nx) {
    const unsigned G = gridDim.x * gridDim.y * gridDim.z;
    unsigned sum, cnt, mine, sp = 0u;
    for (;;) {
        sum = 0u; cnt = 0u; mine = 0u;
#pragma unroll
        for (unsigned j = 0; j < 16; ++j) { const unsigned c = xb_ld(&bar[XB_XCNT(j)]); sum += c; cnt += (c > 0u) ? 1u : 0u; mine = (j == x) ? c : mine; }
        if (sum == G) break;
        __builtin_amdgcn_s_sleep(1);
        if ((++sp & 255u) == 0u) { if (xb_ld(&bar[XB_TMO])) break; if (sp > XB_SPIN_CAP) { atomicAdd(&bar[XB_TMO], 1u); break; } }
    }
    nloc = mine > 0u ? mine : 1u; nx = cnt > 0u ? cnt : 1u;
}

__device__ __forceinline__ void xcd_barrier(const XcdBarrier& b) {
    asm volatile("s_waitcnt vmcnt(0)" ::: "memory");
    __syncthreads();
    if (threadIdx.x == 0) {
        unsigned* bar = b.bar;
        __builtin_amdgcn_s_waitcnt(0);
        unsigned nloc = b.st[0], nx = b.st[1];
        if (nloc == 0u) { xcd_barrier_complete(bar, b.x, nloc, nx); b.st[0] = nloc; b.st[1] = nx; }
        const unsigned old = xb_add(&bar[XB_XSUB(b.x)], 1u);
        const unsigned gen = old / nloc;
        if (old + 1u == (gen + 1u) * nloc) {
            __builtin_amdgcn_fence(__ATOMIC_RELEASE, "agent");
            asm volatile("s_waitcnt vmcnt(0)" ::: "memory");
            const unsigned og = xb_add(&bar[XB_TOP], 1u);
            const unsigned tg = og / nx;
            if (og + 1u == (tg + 1u) * nx) xb_add(&bar[XB_TOPGEN], 1u);
            else XB_SPIN(xb_ld(&bar[XB_TOPGEN]) == tg, bar);
            __builtin_amdgcn_fence(__ATOMIC_ACQUIRE, "agent");
            xb_add(&bar[XB_XGEN(b.x)], 1u);
            asm volatile("s_waitcnt vmcnt(0)" ::: "memory");
        } else {
            XB_SPIN(xb_ld(&bar[XB_XGEN(b.x)]) == gen, bar);
            __builtin_amdgcn_fence(__ATOMIC_ACQUIRE, "agent");
            asm volatile("s_waitcnt vmcnt(0)" ::: "memory");
        }
    }
    __syncthreads();
}

__device__ __forceinline__ void tr_item(const float* W, int ldn, int k0, int nsrc0, bf16* dst, int ldk, LAS float* scr, int lane) {
    const int r = lane >> 4, c4 = lane & 15;
    f32x4 v[16];
#pragma unroll
    for (int i = 0; i < 16; ++i) v[i] = __builtin_nontemporal_load((const f32x4*)(W + (size_t)(k0 + 4 * i + r) * ldn + nsrc0 + 4 * c4));
#pragma unroll
    for (int i = 0; i < 16; ++i) { LAS float* d = scr + (4 * i + r) * 65 + 4 * c4; d[0] = v[i][0]; d[1] = v[i][1]; d[2] = v[i][2]; d[3] = v[i][3]; }
    LDS_WAIT();
    const int c = lane & 7;
#pragma unroll
    for (int j = 0; j < 8; ++j) { const int n = (lane >> 3) + 8 * j; const LAS float* s = scr + (8 * c) * 65 + n;
        u32x4 o; o.x = pk2(s[0 * 65], s[1 * 65]); o.y = pk2(s[2 * 65], s[3 * 65]); o.z = pk2(s[4 * 65], s[5 * 65]); o.w = pk2(s[6 * 65], s[7 * 65]);
        __builtin_nontemporal_store(o, (u32x4*)(dst + (size_t)n * ldk + k0 + 8 * c)); }
    LDS_WAIT();
}
__device__ __forceinline__ int w13_row(int f) { return 256 * (f >> 7) + (f & 127); }

__device__ __forceinline__ void phase_prologue(const Args& a, LAS unsigned char* lds, int gw, int ngw, int wave, int lane, int gtid, int ngt) {
    unsigned char* ws = a.ws;
    LAS float* scr = (LAS float*)(lds + wave * 16640);
    constexpr int N_GEMV = 1536, I_WIN = 768, I_WOUT = 256, I_W1 = 704, I_W2 = 704;
    constexpr int N_ITEMS = N_GEMV + 2 * I_WIN + 2 * I_WOUT + 2 * I_W1 + I_W2;
    { LAS float* sl = (LAS float*)(lds + 133120);
        for (int i = threadIdx.x; i < 3072; i += 512) { const float v = i < 2048 ? a.in[1][i] : a.in[3][i - 2048]; sl[i] = silu_f(v); }
        __syncthreads(); }
    for (int it = gw; it < N_ITEMS; it += ngw) {
        int r = it;
        if (r < N_GEMV) {
            const int grp = r >> 3, kq = r & 7, l = grp / 96, cb = grp % 96, col = 64 * cb + lane;
            const float* wm = a.in[4] + (size_t)l * 1024 * 6144 + (size_t)(128 * kq) * 6144 + col;
            const LAS float* sl = (const LAS float*)(lds + 133120) + 128 * kq;
            float a0[4] = {0.f, 0.f, 0.f, 0.f}, a1[4] = {0.f, 0.f, 0.f, 0.f}, a2[4] = {0.f, 0.f, 0.f, 0.f};
#pragma unroll 4
            for (int k = 0; k < 128; k += 4) {
#pragma unroll
                for (int u = 0; u < 4; ++u) { const float w = wm[(size_t)(k + u) * 6144];
                    a0[u] += sl[k + u] * w; a1[u] += sl[1024 + k + u] * w; a2[u] += sl[2048 + k + u] * w; }
            }
            float* part = (float*)(ws + WS_GAB) + (size_t)r * 192;
            part[lane] = (a0[0] + a0[1]) + (a0[2] + a0[3]); part[64 + lane] = (a1[0] + a1[1]) + (a1[2] + a1[3]); part[128 + lane] = (a2[0] + a2[1]) + (a2[2] + a2[3]);
            __builtin_amdgcn_fence(__ATOMIC_RELEASE, "agent");
            unsigned old = 0; if (lane == 0) old = __hip_atomic_fetch_add((unsigned*)(ws + WS_CTL + 540672) + grp, 1u, __ATOMIC_RELAXED, __HIP_MEMORY_SCOPE_AGENT);
            old = __shfl(old, 0);
            if (old == 7u) { __builtin_amdgcn_fence(__ATOMIC_ACQUIRE, "agent");
                const float* pg = (const float*)(ws + WS_GAB) + (size_t)grp * 8 * 192; const float b = a.in[5][l * 6144 + col];
                float s0 = 0.f, s1 = 0.f, s2 = 0.f;
#pragma unroll
                for (int q = 0; q < 8; ++q) { s0 += __hip_atomic_load(pg + q * 192 + lane, __ATOMIC_RELAXED, __HIP_MEMORY_SCOPE_AGENT); s1 += __hip_atomic_load(pg + q * 192 + 64 + lane, __ATOMIC_RELAXED, __HIP_MEMORY_SCOPE_AGENT); s2 += __hip_atomic_load(pg + q * 192 + 128 + lane, __ATOMIC_RELAXED, __HIP_MEMORY_SCOPE_AGENT); }
                float* mv = (float*)(ws + WS_CTL + CTL_MODV) + (size_t)l * 3 * 6144 + col;
                mv[0] = s0 + b; mv[6144] = s1 + b; mv[2 * 6144] = s2 + b; }
            continue;
        }
        r -= N_GEMV;
        if (r < 2 * I_WIN) { const int l = r / I_WIN, q = r % I_WIN, kb = q / 48, nb = q % 48, n0 = 64 * nb;
            tr_item(a.in[8] + (size_t)l * 1024 * INW, INW, 64 * kb, n0 + (n0 >= 2048 ? 16 : 0), (bf16*)(ws + WS_WIN) + ((size_t)l * 3072 + n0) * 1024, 1024, scr, lane); continue; }
        r -= 2 * I_WIN;
        if (r < 2 * I_WOUT) { const int l = r / I_WOUT, q = r % I_WOUT, kb = q / 16, nb = q % 16;
            tr_item(a.in[17] + (size_t)l * 1024 * 1024, 1024, 64 * kb, 64 * nb, (bf16*)(ws + WS_WOUT) + ((size_t)l * 1024 + 64 * nb) * 1024, 1024, scr, lane); continue; }
        r -= 2 * I_WOUT;
        if (r < 2 * I_W1) { const int which = r / I_W1, q = r % I_W1, kb = q / 44, nb = q % 44;
            tr_item(a.in[which ? 19 : 18], DFF, 64 * kb, 64 * nb, (bf16*)(ws + WS_W13) + (size_t)(w13_row(64 * nb) + 128 * which) * 1024, 1024, scr, lane); continue; }
        r -= 2 * I_W1;
        { const int kb = r / 16, nb = r % 16;
            tr_item(a.in[20], 1024, 64 * kb, 64 * nb, (bf16*)(ws + WS_W2) + (size_t)(64 * nb) * DFF, DFF, scr, lane); }
    }
    for (int i = gtid; i < 16384; i += ngt) { float s, c; sincospif((float)i * (1.0f / 8192.0f), &s, &c); ((f32x2*)(ws + WS_TWID))[i] = (f32x2){c, s}; }
    for (int i = gtid; i < 32768; i += ngt) { const int row = i >> 7, t1 = i & 127, c = row >> 7, kb = row & 127; const float ang = (float)((kb * t1) & 127) * (1.0f / 64.0f);
        ((bf16*)(ws + WS_F1))[i] = f2bf(c == 0 ? cospif(ang) : -sinpif(ang)); }
    for (int i = gtid; i < 65536; i += ngt) { const int row = i >> 8, col = i & 255, c = row >> 7, ka = row & 127, c2 = col >> 7, t0 = col & 127; const float ang = (float)((ka * t0) & 127) * (1.0f / 64.0f);
        const float cs = cospif(ang), sn = sinpif(ang); ((bf16*)(ws + WS_A2))[i] = f2bf(c == c2 ? cs : (c == 0 ? sn : -sn)); }
    for (int i = gtid; i < 131072; i += ngt) { const int kh = i >> 16, row = (i >> 8) & 255, t = i & 255, c = row >> 7, ka = row & 127, k = 128 * kh + ka; const float ang = (float)((k * t) & 255) * (1.0f / 128.0f);
        ((bf16*)(ws + WS_A2C))[i] = f2bf(c == 0 ? cospif(ang) : -sinpif(ang)); }
    for (int i = gtid; i < 262144; i += ngt) { const int l = i >> 17, mt = (i >> 13) & 15, kk = (i >> 9) & 15, ln = (i >> 3) & 63, e = i & 7;
        const int j = 16 * mt + (ln & 15), g = ln >> 4, kidx = 32 * kk + (e < 4 ? 4 * g + e : 16 + 4 * g + e - 4), c = kidx >> 8, ch = kidx & 255, grp = ch >> 6, n = ch & 63;
        const float* fw = a.in[16] + (size_t)l * 65536 + (size_t)(grp * 64) * 256 + j; float s = 0.f;
        for (int m = 0; m < 64; ++m) { const float ang = (float)((m * n) & 63) * (1.0f / 32.0f); s += (c == 0 ? cospif(ang) : sinpif(ang)) * fw[m * 256]; }
        ((bf16*)(ws + WS_WFT))[i] = f2bf(s * (1.0f / 1024.0f)); }
}

__device__ __forceinline__ void phase_A(const Args& a, int l, LAS unsigned char* lds, int gw, int ngw, int tid, int lane) {
    unsigned char* ws = a.ws;
    LAS float* wab = (LAS float*)lds;
    const float* win = a.in[8] + (size_t)l * 1024 * INW + 2048;
    for (int i = tid; i < 16384; i += 512) { const int k = i >> 4, o = i & 15; wab[o * 1024 + k] = win[(size_t)k * INW + o]; }
    __syncthreads();
    const float* gm = a.in[6] + l * 1024;
    const float* modv = (const float*)(ws + WS_CTL + CTL_MODV) + (size_t)l * 3 * 6144;
    const float* xl = l == 0 ? a.in[0] : a.out; const float* xc = l == 0 ? a.in[2] : (const float*)(ws + WS_CTXS);
    bf16* hb = (bf16*)(ws + WS_HBUF); float* gab = (float*)(ws + WS_GAB);
    f32x4 nv[4];
    { const int row = gw < NROW ? gw : 0; const float* xr = row < NLAT ? xl + (size_t)row * 1024 : xc + (size_t)(row - NLAT) * 1024;
#pragma unroll
        for (int j = 0; j < 4; ++j) nv[j] = *(const f32x4*)(xr + 4 * lane + 256 * j); }
    for (int row = gw; row < NROW; row += ngw) {
        const int bi = row < NLAT ? (row >> 14) : 2; const float* md = modv + bi * 6144;
        f32x4 v[4]; float ss = 0.f;
#pragma unroll
        for (int j = 0; j < 4; ++j) v[j] = nv[j];
        { const int rn = row + ngw < NROW ? row + ngw : row; const float* xn = rn < NLAT ? xl + (size_t)rn * 1024 : xc + (size_t)(rn - NLAT) * 1024;
#pragma unroll
            for (int j = 0; j < 4; ++j) nv[j] = *(const f32x4*)(xn + 4 * lane + 256 * j); }
#pragma unroll
        for (int j = 0; j < 4; ++j) ss += (v[j][0] * v[j][0] + v[j][1] * v[j][1]) + (v[j][2] * v[j][2] + v[j][3] * v[j][3]);
        const float rinv = rsqrtf(wave_sum(ss) * (1.0f / 1024.0f) + EPS);
        float p[16];
#pragma unroll
        for (int o = 0; o < 16; ++o) p[o] = 0.f;
#pragma unroll
        for (int j = 0; j < 4; ++j) { const int k = 4 * lane + 256 * j; const f32x4 g4 = *(const f32x4*)(gm + k), sc = *(const f32x4*)(md + 1024 + k), sh = *(const f32x4*)(md + k);
            f32x4 h = v[j] * rinv * g4 * (sc + 1.0f) + sh; v[j] = h;
            *(u32x2*)(hb + (size_t)row * 1024 + k) = (u32x2){pk2(h[0], h[1]), pk2(h[2], h[3])};
#pragma unroll
            for (int o = 0; o < 16; ++o) { const f32x4 w4 = *(const LAS f32x4*)(wab + o * 1024 + k); p[o] += (h[0] * w4[0] + h[1] * w4[1]) + (h[2] * w4[2] + h[3] * w4[3]); } }
        float mine = 0.f;
#pragma unroll
        for (int o = 0; o < 16; ++o) { const float s = wave_sum(p[o]); if (lane == o) mine = s; }
        if (lane < 8) { const float al = mine + a.in[11][l * 8 + lane]; const float sp = fmaxf(al, 0.f) + log1pf(__expf(-fabsf(al)));
            gab[(size_t)row * 16 + lane] = -__expf(a.in[10][l * 8 + lane]) * sp; }
        else if (lane < 16) gab[(size_t)row * 16 + lane] = 1.0f / (1.0f + __expf(-mine));
    }
    __syncthreads();
}
__device__ __forceinline__ void phase_F(const Args& a, int l, LAS unsigned char* lds, int gw, int ngw, int tid, int lane) {
    unsigned char* ws = a.ws;
    LAS float* wrt = (LAS float*)lds;
    if (l == 1) { for (int i = tid; i < 8192; i += 512) { const int k = i >> 3, e = i & 7; wrt[e * 1024 + k] = a.in[21][i]; } __syncthreads(); }
    const float* gm = a.in[7] + l * 1024;
    const float* modv = (const float*)(ws + WS_CTL + CTL_MODV) + (size_t)l * 3 * 6144;
    const float* xl = a.out; const float* xc = (const float*)(ws + WS_CTXS);
    bf16* hb = (bf16*)(ws + WS_HBUF);
    int* tok_e = (int*)(ws + WS_TOK); float* tok_w = (float*)(ws + WS_TOK + 262144);
    const int nrow = l == 0 ? NROW : NLAT; int mycnt = 0;
    const int per = (nrow + ngw - 1) / ngw;
    f32x4 nv[4];
    { const int row = gw * per < nrow ? gw * per : 0; const float* xr = row < NLAT ? xl + (size_t)row * 1024 : xc + (size_t)(row - NLAT) * 1024;
#pragma unroll
        for (int j = 0; j < 4; ++j) nv[j] = *(const f32x4*)(xr + 4 * lane + 256 * j); }
    for (int row = gw * per; row < gw * per + per && row < nrow; ++row) {
        const int bi = row < NLAT ? (row >> 14) : 2; const float* md = modv + bi * 6144;
        f32x4 v[4]; float ss = 0.f;
#pragma unroll
        for (int j = 0; j < 4; ++j) v[j] = nv[j];
        { const int rn = row + 1 < nrow ? row + 1 : row; const float* xn = rn < NLAT ? xl + (size_t)rn * 1024 : xc + (size_t)(rn - NLAT) * 1024;
#pragma unroll
            for (int j = 0; j < 4; ++j) nv[j] = *(const f32x4*)(xn + 4 * lane + 256 * j); }
#pragma unroll
        for (int j = 0; j < 4; ++j) ss += (v[j][0] * v[j][0] + v[j][1] * v[j][1]) + (v[j][2] * v[j][2] + v[j][3] * v[j][3]);
        const float rinv = rsqrtf(wave_sum(ss) * (1.0f / 1024.0f) + EPS);
        float p[8];
#pragma unroll
        for (int o = 0; o < 8; ++o) p[o] = 0.f;
#pragma unroll
        for (int j = 0; j < 4; ++j) { const int k = 4 * lane + 256 * j; const f32x4 g4 = *(const f32x4*)(gm + k), sc = *(const f32x4*)(md + 4096 + k), sh = *(const f32x4*)(md + 3072 + k);
            const f32x4 h = v[j] * rinv * g4 * (sc + 1.0f) + sh;
            *(u32x2*)(hb + (size_t)row * 1024 + k) = (u32x2){pk2(h[0], h[1]), pk2(h[2], h[3])};
            if (l == 1) {
#pragma unroll
                for (int o = 0; o < 8; ++o) { const f32x4 w4 = *(const LAS f32x4*)(wrt + o * 1024 + k); p[o] += (h[0] * w4[0] + h[1] * w4[1]) + (h[2] * w4[2] + h[3] * w4[3]); } } }
        if (l == 1) {
            float lg[8];
#pragma unroll
            for (int o = 0; o < 8; ++o) lg[o] = wave_sum(p[o]);
            int e0 = 0; float l0 = lg[0];
#pragma unroll
            for (int o = 1; o < 8; ++o) if (lg[o] > l0) { l0 = lg[o]; e0 = o; }
            int e1 = -1; float l1 = -3.0e38f;
#pragma unroll
            for (int o = 0; o < 8; ++o) if (o != e0 && lg[o] > l1) { l1 = lg[o]; e1 = o; }
            const float w1 = 1.0f / (1.0f + __expf(l0 - l1)), w0 = 1.0f - w1;
            if (lane == 0) { tok_e[2 * row] = e0; tok_e[2 * row + 1] = e1; tok_w[2 * row] = w0; tok_w[2 * row + 1] = w1; }
            mycnt += (lane == e0) + (lane == e1);
        }
    }
    if (l == 1 && lane < 8 && mycnt > 0) atomicAdd((int*)(ws + WS_CTL + CTL_CNT) + lane, mycnt);
    if (l == 1 && lane < 8) ((int*)(ws + WS_CTL + 262144))[gw * 8 + lane] = mycnt;
    __syncthreads();
}
namespace pg8 {
struct EpiProj {
    static constexpr bool PERM = true, AFTER_DRAIN = false; unsigned char* ws;
    __device__ __forceinline__ void operator()(const f32x4 (&acc)[2][2][4][2], const Unit& u, int wr, int wc, int fr, int fq) const {
        const int row0 = u.pm * BM + wr * 64 + fr, pn = u.pn; bf16_t* base; int ldc, colt;
        if (pn < 6) { base = (bf16_t*)(ws + WS_QKV); ldc = 1536; colt = pn * 256; } else if (pn < 8) { base = (bf16_t*)(ws + WS_Z); ldc = 512; colt = (pn - 6) * 256; }
        else if (pn < 11) { base = (bf16_t*)(ws + WS_NA); ldc = 768; colt = (pn - 8) * 256; } else { base = (bf16_t*)(ws + WS_FT); ldc = 256; colt = 0; }
        const int col0 = colt + wc * 32 + 8 * fq;
#pragma unroll
        for (int ai = 0; ai < 2; ++ai)
#pragma unroll
            for (int m = 0; m < 4; ++m) { bf16_t* rowp = base + (size_t)(row0 + ai * HALF + m * 16) * ldc + col0;
#pragma unroll
                for (int bj = 0; bj < 2; ++bj) { const f32x4 v0 = acc[ai][bj][m][0], v1 = acc[ai][bj][m][1];
                    u32x4 w; w.x = cvt_pk_bf16(v0[0], v0[1]); w.y = cvt_pk_bf16(v0[2], v0[3]); w.z = cvt_pk_bf16(v1[0], v1[1]); w.w = cvt_pk_bf16(v1[2], v1[3]);
                    *(u32x4*)(rowp + bj * HALF) = w; } }
    }
};
struct EpiResid {
    static constexpr bool PERM = false, AFTER_DRAIN = false;
    const float* src_lat; const float* src_ctx; float* dst_lat; float* dst_ctx; const float* gate;
    __device__ __forceinline__ void operator()(const f32x4 (&acc)[2][2][4][2], const Unit& u, int wr, int wc, int fr, int fq) const {
        const int row0 = u.pm * BM + wr * 64 + fr, col0 = u.pn * BM + wc * 32 + 4 * fq;
#pragma unroll
        for (int ai = 0; ai < 2; ++ai)
#pragma unroll
            for (int m = 0; m < 4; ++m) { const int row = row0 + ai * HALF + m * 16; const bool lat = row < NLAT; const size_t ro = lat ? (size_t)row * 1024 : (size_t)(row - NLAT) * 1024;
                const float* s = (lat ? src_lat : src_ctx) + ro + col0; float* d = (lat ? dst_lat : dst_ctx) + ro + col0; const float* g = gate + (lat ? (row >> 14) : 2) * 6144 + col0;
#pragma unroll
                for (int bj = 0; bj < 2; ++bj)
#pragma unroll
                    for (int n = 0; n < 2; ++n) { const int o = bj * HALF + n * 16; *(f32x4*)(d + o) = *(const f32x4*)(s + o) + *(const f32x4*)(g + o) * acc[ai][bj][m][n]; } }
    }
};
struct EpiSwiglu {
    static constexpr bool PERM = true, AFTER_DRAIN = false; bf16_t* act; int ldc; int row_off;
    __device__ __forceinline__ void operator()(const f32x4 (&acc)[2][2][4][2], const Unit& u, int wr, int wc, int fr, int fq) const {
        const int row0 = u.pm * BM - row_off + wr * 64 + fr, col0 = u.pn * HALF + wc * 32 + 8 * fq;
#pragma unroll
        for (int ai = 0; ai < 2; ++ai)
#pragma unroll
            for (int m = 0; m < 4; ++m) { bf16_t* rowp = act + (size_t)(row0 + ai * HALF + m * 16) * ldc + col0;
                float o[8];
#pragma unroll
                for (int n = 0; n < 2; ++n)
#pragma unroll
                    for (int i = 0; i < 4; ++i) { const float x = acc[ai][0][m][n][i], y = acc[ai][1][m][n][i]; o[4 * n + i] = x / (1.0f + __expf(-x)) * y; }
                u32x4 w; w.x = cvt_pk_bf16(o[0], o[1]); w.y = cvt_pk_bf16(o[2], o[3]); w.z = cvt_pk_bf16(o[4], o[5]); w.w = cvt_pk_bf16(o[6], o[7]);
                *(u32x4*)rowp = w; }
    }
};
struct EpiBf16Out {
    static constexpr bool PERM = true, AFTER_DRAIN = false; bf16_t* O; int ldc;
    __device__ __forceinline__ void operator()(const f32x4 (&acc)[2][2][4][2], const Unit& u, int wr, int wc, int fr, int fq) const {
        const int row0 = u.pm * BM + wr * 64 + fr, col0 = u.pn * BM + wc * 32 + 8 * fq;
#pragma unroll
        for (int ai = 0; ai < 2; ++ai)
#pragma unroll
            for (int m = 0; m < 4; ++m) { bf16_t* rowp = O + (size_t)(row0 + ai * HALF + m * 16) * ldc + col0;
#pragma unroll
                for (int bj = 0; bj < 2; ++bj) { const f32x4 v0 = acc[ai][bj][m][0], v1 = acc[ai][bj][m][1];
                    u32x4 w; w.x = cvt_pk_bf16(v0[0], v0[1]); w.y = cvt_pk_bf16(v0[2], v0[3]); w.z = cvt_pk_bf16(v1[0], v1[1]); w.w = cvt_pk_bf16(v1[2], v1[3]);
                    *(u32x4*)(rowp + bj * HALF) = w; } }
    }
};
struct MoeOrder {
    int nM, nN, mb0, G, c; int ps[8]; size_t estride;
    __device__ __forceinline__ bool next(int i, Unit& u) const { const long L = (long)i * G + c; if (L >= (long)nM * nN) return false; u.pm = mb0 + (int)(L % nM); u.pn = (int)(L / nM); return true; }
    __device__ __forceinline__ void a_ready(const Unit&) const {}
    __device__ __forceinline__ void done(const Unit&) const {}
    __device__ __forceinline__ const char* bptr(const Gemm& g, const Unit& u, size_t tstep) const { const int slot = u.pm << 8; int e = 0;
#pragma unroll
        for (int i = 1; i < 8; ++i) e += slot >= ps[i] ? 1 : 0;
        return (const char*)g.Bt + (size_t)e * estride + (size_t)u.pn * tstep; }
};
}

__device__ __forceinline__ void moe_pads(const unsigned char* ws, int (&ps)[9]) {
    const int* cnt = (const int*)(ws + WS_CTL + CTL_CNT); int acc = 0;
#pragma unroll
    for (int e = 0; e < 8; ++e) { ps[e] = acc; const int c = __builtin_amdgcn_readfirstlane(__hip_atomic_load(cnt + e, __ATOMIC_RELAXED, __HIP_MEMORY_SCOPE_AGENT)); acc += (c + 255) / 256 * 256; }
    ps[8] = acc;
}
__device__ __forceinline__ void phase_moe_assign(const Args& a, int gw, int lane) {
    unsigned char* ws = a.ws;
    int ps[9]; moe_pads(ws, ps);
    const int* tok_e = (const int*)(ws + WS_TOK); const float* tok_w = (const float*)(ws + WS_TOK + 262144); int* tok_slot = (int*)(ws + WS_TOK + 524288);
    int* slot_tok = (int*)(ws + WS_SLOT); float* slot_w = (float*)(ws + WS_SLOT + 270336);
    const bf16* hb = (const bf16*)(ws + WS_HBUF); bf16* xb = (bf16*)(ws + WS_XB);
    const int row = gw * 16 + (lane & 15), k = (lane >> 4) & 1; const bool act = lane < 32;
    const int e = act ? tok_e[2 * row + k] : -1; int slot = 0;
    int sb[8];
#pragma unroll
    for (int ee = 0; ee < 8; ++ee) sb[ee] = 0;
    { typedef int i32x4 __attribute__((ext_vector_type(4))); const i32x4* wc4 = (const i32x4*)(ws + WS_CTL + 262144);
#pragma unroll 4
        for (int w = lane; w < gw; w += 64) { const i32x4 c0 = wc4[2 * w], c1 = wc4[2 * w + 1];
            sb[0] += c0.x; sb[1] += c0.y; sb[2] += c0.z; sb[3] += c0.w; sb[4] += c1.x; sb[5] += c1.y; sb[6] += c1.z; sb[7] += c1.w; } }
#pragma unroll
    for (int ee = 0; ee < 8; ++ee) {
        const unsigned long long mask = __ballot(e == ee);
        int t = sb[ee];
#pragma unroll
        for (int o = 1; o < 64; o <<= 1) t += __shfl_xor(t, o);
        if (e == ee) slot = ps[ee] + t + __popcll(mask & ((1ull << lane) - 1ull));
    }
    if (act) { slot_tok[slot] = row; slot_w[slot] = tok_w[2 * row + k]; tok_slot[2 * row + k] = slot; }
#pragma unroll 4
    for (int i = 0; i < 32; ++i) { const int r = __shfl(row, i), s = __shfl(slot, i);
        const u32x4* src = (const u32x4*)(hb + (size_t)r * 1024); u32x4* dst = (u32x4*)(xb + (size_t)s * 1024);
        dst[lane] = src[lane]; dst[lane + 64] = src[lane + 64]; }
}
struct TrDesc { const float* src; bf16* dst; int ldn, ldk; };
__device__ __forceinline__ TrDesc moe_tr_desc(const Args& a, int it) {
    constexpr int I_W1 = 16 * 56, I_W2 = 56 * 16, PER_E = 2 * I_W1 + I_W2; unsigned char* ws = a.ws;
    const int e = it / PER_E; int r = it % PER_E; TrDesc d;
    if (r < 2 * I_W1) { const int which = r / I_W1, q = r % I_W1, kb = q / 56, nb = q % 56;
        d.src = a.in[which ? 23 : 22] + (size_t)e * 1024 * DFFE + (size_t)(64 * kb) * DFFE + 64 * nb; d.ldn = DFFE;
        d.dst = (bf16*)(ws + WS_MW13) + ((size_t)e * 7168 + w13_row(64 * nb) + 128 * which) * 1024 + 64 * kb; d.ldk = 1024; }
    else { r -= 2 * I_W1; const int kb = r / 16, nb = r % 16;
        d.src = a.in[24] + (size_t)e * DFFE * 1024 + (size_t)(64 * kb) * 1024 + 64 * nb; d.ldn = 1024;
        d.dst = (bf16*)(ws + WS_MW2) + ((size_t)e * 1024 + 64 * nb) * DFFE + 64 * kb; d.ldk = DFFE; }
    return d;
}
__device__ __forceinline__ void phase_moe_convert(const Args& a, LAS unsigned char* lds, int gw, int ngw, int wave, int lane) {
    LAS float* scr = (LAS float*)(lds + wave * 16640);
    constexpr int NIT = 8 * (2 * 16 * 56 + 56 * 16);
    const int r = lane >> 4, c4 = lane & 15, c = lane & 7;
    if (gw >= NIT) return;
    TrDesc cur = moe_tr_desc(a, gw);
    f32x4 v[16];
#pragma unroll
    for (int i = 0; i < 16; ++i) v[i] = __builtin_nontemporal_load((const f32x4*)(cur.src + (size_t)(4 * i + r) * cur.ldn + 4 * c4));
#pragma unroll 1
    for (int it = gw; it < NIT; it += ngw) {
        const bool more = it + ngw < NIT; TrDesc nxt = more ? moe_tr_desc(a, it + ngw) : cur;
        f32x4 nv[16];
#pragma unroll
        for (int i = 0; i < 16; ++i) nv[i] = __builtin_nontemporal_load((const f32x4*)(nxt.src + (size_t)(4 * i + r) * nxt.ldn + 4 * c4));
#pragma unroll
        for (int i = 0; i < 16; ++i) { LAS float* d = scr + (4 * i + r) * 65 + 4 * c4; d[0] = v[i][0]; d[1] = v[i][1]; d[2] = v[i][2]; d[3] = v[i][3]; }
        LDS_WAIT();
#pragma unroll
        for (int j = 0; j < 8; ++j) { const int n = (lane >> 3) + 8 * j; const LAS float* s = scr + (8 * c) * 65 + n;
            u32x4 o; o.x = pk2(s[0 * 65], s[1 * 65]); o.y = pk2(s[2 * 65], s[3 * 65]); o.z = pk2(s[4 * 65], s[5 * 65]); o.w = pk2(s[6 * 65], s[7 * 65]);
            __builtin_nontemporal_store(o, (u32x4*)(cur.dst + (size_t)n * cur.ldk + 8 * c)); }
        LDS_WAIT();
#pragma unroll
        for (int i = 0; i < 16; ++i) v[i] = nv[i];
        cur = nxt;
    }
}
__device__ __forceinline__ void phase_moe_combine(const Args& a, int gw, int ngw, int lane) {
    unsigned char* ws = a.ws;
    const float* tok_w = (const float*)(ws + WS_TOK + 262144); const int* tok_slot = (const int*)(ws + WS_TOK + 524288);
    const bf16* y = (const bf16*)(ws + WS_XB);
    const float* gate = (const float*)(ws + WS_CTL + CTL_MODV) + (size_t)3 * 6144 + 5120;
    auto ld_idx = [&](int row, int& s0, int& s1, float& w0, float& w1) { const int r = row < NLAT ? row : gw; s0 = tok_slot[2 * r]; s1 = tok_slot[2 * r + 1]; w0 = tok_w[2 * r]; w1 = tok_w[2 * r + 1]; };
    int s0c, s1c, s0n, s1n; float w0c, w1c, w0n, w1n;
    ld_idx(gw, s0c, s1c, w0c, w1c); ld_idx(gw + ngw, s0n, s1n, w0n, w1n);
    f32x4 xc[4]; u32x2 yac[4], ybc[4];
    { const float* xr0 = a.out + (size_t)gw * 1024;
#pragma unroll
        for (int j = 0; j < 4; ++j) { const int k = 4 * lane + 256 * j; xc[j] = *(const f32x4*)(xr0 + k); yac[j] = *(const u32x2*)(y + (size_t)s0c * 1024 + k); ybc[j] = *(const u32x2*)(y + (size_t)s1c * 1024 + k); } }
    for (int row = gw; row < NLAT; row += ngw) {
        int s0f, s1f; float w0f, w1f; ld_idx(row + 2 * ngw, s0f, s1f, w0f, w1f);
        f32x4 xn[4]; u32x2 yan[4], ybn[4];
        { const int rn = row + ngw < NLAT ? row + ngw : row; const float* xr2 = a.out + (size_t)rn * 1024;
#pragma unroll
            for (int j = 0; j < 4; ++j) { const int k = 4 * lane + 256 * j; xn[j] = *(const f32x4*)(xr2 + k); yan[j] = *(const u32x2*)(y + (size_t)s0n * 1024 + k); ybn[j] = *(const u32x2*)(y + (size_t)s1n * 1024 + k); } }
        float* xr = a.out + (size_t)row * 1024; const float* g = gate + (row >> 14) * 6144; const float w0 = w0c, w1 = w1c;
#pragma unroll
        for (int j = 0; j < 4; ++j) { const int k = 4 * lane + 256 * j; const u32x2 ya = yac[j], yb = ybc[j];
            f32x4 m; m[0] = w0 * bflo(ya.x) + w1 * bflo(yb.x); m[1] = w0 * bfhi(ya.x) + w1 * bfhi(yb.x); m[2] = w0 * bflo(ya.y) + w1 * bflo(yb.y); m[3] = w0 * bfhi(ya.y) + w1 * bfhi(yb.y);
            *(f32x4*)(xr + k) = xc[j] + *(const f32x4*)(g + k) * m; }
#pragma unroll
        for (int j = 0; j < 4; ++j) { xc[j] = xn[j]; yac[j] = yan[j]; ybc[j] = ybn[j]; }
        s0c = s0n; s1c = s1n; w0c = w0n; w1c = w1n; s0n = s0f; s1n = s1f; w0n = w0f; w1n = w1f;
    }
}
constexpr int PQ = 0, PK = 17408, PV = 34816, PKK = 52224, PAS = 85504, PTS = 118272, PGC = 136704;
__device__ __forceinline__ void dn_prep_item(const Args& a, int l, int item, LAS unsigned char* lds, int tid, int wave, int lane) {
    unsigned char* ws = a.ws;
    const int h = item & 3, cs = (item >> 2) % 260, b = (item >> 2) / 260;
    const int rowbase = cs < 4 ? NLAT + b * CTXL + 64 * cs : b * SEQ + 64 * (cs - 4);
    const int seqlo = cs < 4 ? NLAT + b * CTXL : b * SEQ, seqhi = cs < 4 ? seqlo + CTXL : seqlo + SEQ;
    const bf16* qkv = (const bf16*)(ws + WS_QKV);
    unsigned char* dns = ws + WS_DNS + (size_t)item * DNS_ITEM;
    float gpre = 0.f, bpre = 0.f;
    if (wave < 2) { const int tok = wave ? 63 - lane : lane; const float* gb = (const float*)(ws + WS_GAB) + (size_t)(rowbase + tok) * 16; gpre = gb[wave * 4 + h]; bpre = gb[8 + wave * 4 + h]; }
    { LAS float* cwl = (LAS float*)(lds + PAS);
        for (int i = tid; i < 1152; i += 512) { const int sj = i >> 7, c = i & 127, sec = sj / 3, j = sj % 3; cwl[i] = a.in[9][(size_t)l * 3 * 1536 + j * 1536 + sec * 512 + h * 128 + c]; } }
    __syncthreads();
    {
        const int r = tid >> 3, cgp = tid & 7, row = rowbase + r;
        float vals[3][16];
#pragma unroll
        for (int sec = 0; sec < 3; ++sec) {
            const int ch = sec * 512 + h * 128 + cgp * 16;
            const LAS float* cw = (const LAS float*)(lds + PAS) + sec * 384 + cgp * 16;
            float acc[16];
#pragma unroll
            for (int e = 0; e < 16; ++e) acc[e] = 0.f;
            u32x4 P[3][2]; float msk[3];
#pragma unroll
            for (int j = 0; j < 3; ++j) { const int rr = row + j - 1; msk[j] = (rr >= seqlo && rr < seqhi) ? 1.0f : 0.0f; const int rc = min(max(rr, seqlo), seqhi - 1);
                P[j][0] = *(const u32x4*)(qkv + (size_t)rc * 1536 + ch); P[j][1] = *(const u32x4*)(qkv + (size_t)rc * 1536 + ch + 8); }
#pragma unroll
            for (int j = 0; j < 3; ++j) { const u32x4 p0 = P[j][0], p1 = P[j][1]; const float m = msk[j];
                    const unsigned pw[8] = {p0.x, p0.y, p0.z, p0.w, p1.x, p1.y, p1.z, p1.w};
#pragma unroll
                    for (int e = 0; e < 8; ++e) { acc[2 * e] += bflo(pw[e]) * (cw[j * 128 + 2 * e] * m); acc[2 * e + 1] += bfhi(pw[e]) * (cw[j * 128 + 2 * e + 1] * m); } }
#pragma unroll
            for (int e = 0; e < 16; ++e) vals[sec][e] = silu_f(acc[e]);
            __builtin_amdgcn_sched_barrier(0);
        }
#pragma unroll
        for (int sec = 0; sec < 3; ++sec) {
            float sc = 1.0f;
            if (sec < 2) { float ss = 0.f;
#pragma unroll
                for (int e = 0; e < 16; ++e) ss += vals[sec][e] * vals[sec][e];
                ss += __shfl_xor(ss, 1); ss += __shfl_xor(ss, 2); ss += __shfl_xor(ss, 4);
                sc = rsqrtf(ss + EPS); }
            LAS unsigned* dst = (LAS unsigned*)(lds + (sec == 0 ? PQ : sec == 1 ? PK : PV) + r * 272 + cgp * 32);
#pragma unroll
            for (int e = 0; e < 8; ++e) dst[e] = pk2(vals[sec][2 * e] * sc, vals[sec][2 * e + 1] * sc);
        }
    }
    __syncthreads();
    {
#pragma unroll
        for (int i = 0; i < 2; ++i) { const int p = tid + 512 * i, mt = p >> 8, kk = (p >> 6) & 3, ln = p & 63, row = 16 * mt + (ln & 15), g = ln >> 4;
            const LAS unsigned char* src = lds + PQ + row * 272 + (32 * kk + 4 * g) * 2;
            const u32x2 lo = *(const LAS u32x2*)src, hi = *(const LAS u32x2*)(src + 32);
            *(u32x4*)(dns + (size_t)p * 16) = (u32x4){lo.x, lo.y, hi.x, hi.y}; }
        for (int p = tid; p < 1088; p += 512) *(u32x4*)(dns + 16384 + (size_t)p * 16) = *(const LAS u32x4*)(lds + PK + p * 16);
#pragma unroll
        for (int i = 0; i < 4; ++i) { const int p = tid + 512 * i, s = p >> 8, mt = (p >> 6) & 3, ln = p & 63, tok = 16 * mt + 4 * (ln >> 4), dv = 16 * s + (ln & 15);
            const LAS bf16* vs = (const LAS bf16*)(lds + PV);
            *(u32x2*)(dns + 33792 + (size_t)p * 8) = (u32x2){(unsigned)vs[tok * 136 + dv] | ((unsigned)vs[(tok + 1) * 136 + dv] << 16), (unsigned)vs[(tok + 2) * 136 + dv] | ((unsigned)vs[(tok + 3) * 136 + dv] << 16)}; }
    }
    {
#pragma unroll
        for (int t = 0; t < 4; ++t) { const int T = 4 * wave + t, which = T >> 4, ti = (T >> 2) & 3, tj = T & 3; f32x4 acc = {0.f, 0.f, 0.f, 0.f};
#pragma unroll
            for (int kk = 0; kk < 4; ++kk) { const bf16x8 av = *(const LAS bf16x8*)(lds + (which ? PQ : PK) + (16 * ti + (lane & 15)) * 272 + (32 * kk + 8 * (lane >> 4)) * 2);
                const bf16x8 bv = *(const LAS bf16x8*)(lds + PK + (16 * tj + (lane & 15)) * 272 + (32 * kk + 8 * (lane >> 4)) * 2);
                acc = MFMA16(av, bv, acc); }
            LAS float* o = (LAS float*)(lds + PKK) + which * 4160 + (16 * ti + 4 * (lane >> 4)) * 65 + 16 * tj + (lane & 15);
#pragma unroll
            for (int r = 0; r < 4; ++r) o[r * 65] = acc[r]; }
    }
    if (wave < 2) { const int d = wave, tok = d ? 63 - lane : lane;
        float gc = gpre; const float bt = bpre;
#pragma unroll
        for (int o = 1; o < 64; o <<= 1) { const float t = __shfl_up(gc, o); if (lane >= o) gc += t; }
        const float glast = __shfl(gc, 63);
        LAS float* gcs = (LAS float*)(lds + PGC) + d * 128; gcs[tok] = gc; gcs[64 + tok] = bt;
        float* aux = (float*)(ws + WS_DND + (size_t)(item * 2 + d) * DND_ITEM + 16384);
        aux[tok] = bt; aux[64 + tok] = __expf(gc); aux[128 + tok] = __expf(glast - gc); if (lane == 0) aux[192] = __expf(glast); }
    __syncthreads();
    {
        const LAS float* kkm = (const LAS float*)(lds + PKK); const LAS float* qkm = kkm + 4160;
#pragma unroll
        for (int d = 0; d < 2; ++d) { const LAS float* gcs = (const LAS float*)(lds + PGC) + d * 128; LAS float* as = (LAS float*)(lds + PAS) + d * 4096;
            for (int idx = tid; idx < 4096; idx += 512) { const int p = idx >> 6, p2 = idx & 63, i = d ? 63 - p : p, j = d ? 63 - p2 : p2;
                as[idx] = p2 < p ? gcs[64 + i] * kkm[i * 65 + j] * __expf(gcs[i] - gcs[j]) : 0.f; }
            { const int mt = tid >> 7, kk = (tid >> 6) & 1, ln = tid & 63, i = 16 * mt + (ln & 15), g = ln >> 4; float v[8];
#pragma unroll
                for (int e = 0; e < 8; ++e) { const int j = 32 * kk + (e < 4 ? 4 * g + e : 16 + 4 * g + e - 4); const bool ok = d ? (j >= i) : (j <= i);
                    v[e] = ok ? qkm[i * 65 + j] * __expf(gcs[i] - gcs[j]) * 0.08838834764831845f : 0.f; }
                *(u32x4*)(ws + WS_DND + (size_t)(item * 2 + d) * DND_ITEM + 8192 + (size_t)tid * 16) = (u32x4){pk2(v[0], v[1]), pk2(v[2], v[3]), pk2(v[4], v[5]), pk2(v[6], v[7])}; }
        }
    }
    __syncthreads();
    if (wave < 2) { const int d = wave; const LAS float* as = (const LAS float*)(lds + PAS) + d * 4096; float t[64];
        t[0] = (lane == 0) ? 1.0f : 0.0f;
        int ar = __float_as_int(as[64 + lane]);
#pragma unroll
        for (int p = 1; p < 64; ++p) {
            const int an = __float_as_int(as[((p + 1) & 63) * 64 + lane]);
            float acc = (p == lane) ? 1.0f : 0.0f;
#pragma unroll
            for (int p2 = 0; p2 < p; ++p2) acc -= __int_as_float(__builtin_amdgcn_readlane(ar, p2)) * t[p2];
            t[p] = acc; ar = an; }
        LAS bf16* ts = (LAS bf16*)(lds + PTS) + d * 4608; const int jc = d ? 63 - lane : lane;
#pragma unroll
        for (int p = 0; p < 64; ++p) { const int i = d ? 63 - p : p; ts[i * 72 + jc] = f2bf(t[p]); } }
    __syncthreads();
    {
#pragma unroll
        for (int d = 0; d < 2; ++d) { const int mt = tid >> 7, kk = (tid >> 6) & 1, ln = tid & 63, i = 16 * mt + (ln & 15), g = ln >> 4;
            const LAS unsigned char* src = lds + PTS + d * 9216 + i * 144 + (32 * kk + 4 * g) * 2;
            const u32x2 lo = *(const LAS u32x2*)src, hi = *(const LAS u32x2*)(src + 32);
            *(u32x4*)(ws + WS_DND + (size_t)(item * 2 + d) * DND_ITEM + (size_t)tid * 16) = (u32x4){lo.x, lo.y, hi.x, hi.y}; }
    }
    __syncthreads();
}

__device__ __forceinline__ void na_prep_item(const Args& a, int l, int item8, int lane) {
    unsigned char* ws = a.ws; const int item = item8 >> 3, part = item8 & 7;
    const int row = item * 64 + lane;
    bf16* na = (bf16*)(ws + WS_NA) + (size_t)row * 768; bf16* vt = (bf16*)(ws + WS_VT);
    const int b = row < NLAT ? (row >> 14) : ((row - NLAT) >> 8), tpos = row < NLAT ? (row & 16383) : 16384 + ((row - NLAT) & 255);
    const float* qn = a.in[13] + l * 64; const float* kn = a.in[14] + l * 64;
    { const int sec = part >> 2, h = part & 3;
        { u32x4* p = (u32x4*)(na + sec * 256 + h * 64); u32x4 v[8]; float ss = 0.f;
#pragma unroll
            for (int i = 0; i < 8; ++i) { v[i] = p[i]; const unsigned w[4] = {v[i].x, v[i].y, v[i].z, v[i].w};
#pragma unroll
                for (int e = 0; e < 4; ++e) { const float x = bflo(w[e]), y = bfhi(w[e]); ss += x * x + y * y; } }
            const float sc = rsqrtf(ss * (1.0f / 64.0f) + EPS); const float* nw = sec == 0 ? qn : kn;
#pragma unroll
            for (int i = 0; i < 8; ++i) { const unsigned w[4] = {v[i].x, v[i].y, v[i].z, v[i].w}; unsigned o[4];
#pragma unroll
                for (int e = 0; e < 4; ++e) o[e] = pk2(bflo(w[e]) * sc * nw[8 * i + 2 * e], bfhi(w[e]) * sc * nw[8 * i + 2 * e + 1]);
                p[i] = (u32x4){o[0], o[1], o[2], o[3]}; } } }
    if (part < 4) { const int h = part; const u32x4* p = (const u32x4*)(na + 512 + h * 64); bf16* dst = vt + ((size_t)(b * 4 + h) * 64) * 16640 + tpos;
#pragma unroll
        for (int i = 0; i < 8; ++i) { const u32x4 v = p[i]; const unsigned w[4] = {v.x, v.y, v.z, v.w};
#pragma unroll
            for (int e = 0; e < 4; ++e) { dst[(size_t)(8 * i + 2 * e) * 16640] = (bf16)(w[e] & 0xffffu); dst[(size_t)(8 * i + 2 * e + 1) * 16640] = (bf16)(w[e] >> 16); } } }
}

__device__ __forceinline__ void ft_stage1_item(const Args& a, int item, LAS unsigned char* lds, int tid, int wave, int lane) {
    unsigned char* ws = a.ws; const int b = item >> 7, t0 = item & 127;
    const bf16* ft = (const bf16*)(ws + WS_FT);
#pragma unroll
    for (int i = 0; i < 8; ++i) { const int p = tid + 512 * i, t1 = p >> 5, cp = p & 31;
        *(LAS u32x4*)(lds + t1 * 528 + cp * 16) = *(const u32x4*)(ft + (size_t)(b * SEQ + 128 * t1 + t0) * 256 + cp * 8); }
    __syncthreads();
    const int fr = lane & 15, g = lane >> 4, q = fr >> 2, pp = fr & 3;
    const bf16* f1 = (const bf16*)(ws + WS_F1);
    bf16x8 af[2][4];
#pragma unroll
    for (int c = 0; c < 2; ++c)
#pragma unroll
        for (int kk = 0; kk < 4; ++kk) af[c][kk] = *(const bf16x8*)(f1 + (size_t)(c * 128 + 16 * wave + fr) * 128 + 32 * kk + 8 * g);
    const f32x2* tw = (const f32x2*)(ws + WS_TWID); f32x2 twv[4];
#pragma unroll
    for (int r = 0; r < 4; ++r) twv[r] = tw[((16 * wave + 4 * g + r) * t0) & 16383];
    bf16* yb = (bf16*)(ws + WS_Y);
    const unsigned lbase = (unsigned)(size_t)(lds) + (8 * g + q) * 528 + 8 * pp;
#pragma unroll 2
    for (int nt = 0; nt < 16; ++nt) { f32x4 yr = {0.f, 0.f, 0.f, 0.f}, yi = {0.f, 0.f, 0.f, 0.f};
        u32x2 t[8];
#pragma unroll
        for (int kk = 0; kk < 4; ++kk) { const unsigned ad = lbase + 32 * kk * 528 + 32 * nt; t[2 * kk] = tr_issue(ad); t[2 * kk + 1] = tr_issue(ad + 4 * 528); }
        tr_wait8(t[0], t[1], t[2], t[3], t[4], t[5], t[6], t[7]);
#pragma unroll
        for (int kk = 0; kk < 4; ++kk) { const bf16x8 bv = mk8(t[2 * kk].x, t[2 * kk].y, t[2 * kk + 1].x, t[2 * kk + 1].y);
            yr = MFMA16(af[0][kk], bv, yr); yi = MFMA16(af[1][kk], bv, yi); }
#pragma unroll
        for (int r = 0; r < 4; ++r) { const int kb = 16 * wave + 4 * g + r; const float cs = twv[r][0], sn = twv[r][1];
            const float pr = yr[r] * cs + yi[r] * sn, pi = yi[r] * cs - yr[r] * sn;
            const size_t o = ((((size_t)b * 128 + kb) * 2) * 128 + t0) * 256 + 16 * nt + fr;
            yb[o] = f2bf(pr); yb[o + 128 * 256] = f2bf(pi); } }
    __syncthreads();
}
constexpr int SC_Q = 0, SC_K = 16384, SC_T = 33792, SC_QK = 41984, SC_AUX = 50176, SC_BUF = 51200, SC_RPB = 0;
__device__ __forceinline__ void scan_issue(const unsigned char* ws, int item, int d, LAS unsigned char* buf, int wave, int lane) {
    const unsigned char* gs = ws + WS_DNS + (size_t)item * DNS_ITEM + lane * 16;
    const unsigned char* gd = ws + WS_DND + (size_t)(item * 2 + d) * DND_ITEM + lane * 16;
#pragma unroll 1
    for (int i = wave - 2; i < 50; i += 6) { const unsigned char* src = i < 33 ? gs + i * 1024 : gd + (i - 33) * 1024;
        __builtin_amdgcn_global_load_lds((const unsigned*)src, (LAS unsigned*)(buf + i * 1024), 16, 0, 0); }
}
__device__ __forceinline__ void scan_block(const Args& a, int chain, int sg, LAS unsigned char* lds, int wave, int lane) {
    const unsigned char* ws = a.ws;
    const int h = chain & 3, d = (chain >> 2) & 1, b = chain >> 3, fr = lane & 15, g = lane >> 4, s = 2 * sg + (wave & 1);
    bf16* obuf = (bf16*)(ws + WS_HBUF) + (size_t)d * NROW * 512;
    f32x4 S[8];
#pragma unroll
    for (int i = 0; i < 8; ++i) S[i] = (f32x4){0.f, 0.f, 0.f, 0.f};
    auto item_of = [&](int step) { const int cs = step < 4 ? (d ? 3 - step : step) : 4 + (d ? 259 - step : step - 4); return ((b * 260 + cs) << 2) + h; };
    auto load_v = [&](int step, u32x2 (&vv)[4]) { const unsigned char* gv = ws + WS_DNS + (size_t)item_of(step) * DNS_ITEM + 33792 + s * 2048 + lane * 8;
#pragma unroll
        for (int mt = 0; mt < 4; ++mt) vv[mt] = *(const u32x2*)(gv + mt * 512); };
    u32x2 vcur[4], vnxt[4];
#pragma unroll
    for (int mt = 0; mt < 4; ++mt) { vcur[mt] = (u32x2){0u, 0u}; vnxt[mt] = (u32x2){0u, 0u}; }
    if (wave >= 2) { scan_issue(ws, item_of(0), d, lds, wave, lane); scan_issue(ws, item_of(1), d, lds + SC_BUF, wave, lane); }
    if (wave < 2) load_v(0, vcur);
    VM_WAIT(); __builtin_amdgcn_s_barrier(); asm volatile("" ::: "memory");
    int bsel = 0;
#pragma unroll 1
    for (int step = 0; step < 260; ++step) {
        const int b2 = bsel >= 1 ? bsel - 1 : 2;
        if (wave >= 2 && step + 2 < 260) scan_issue(ws, item_of(step + 2), d, lds + b2 * SC_BUF, wave, lane);
        if (wave < 2) {
        if (step + 1 < 260) load_v(step + 1, vnxt);
        LAS unsigned char* bf = lds + bsel * SC_BUF;
        const unsigned ktbase = (unsigned)(size_t)bf + SC_K + (4 * g + (fr >> 2)) * 272 + 8 * (fr & 3);
        const int cs = step < 4 ? (d ? 3 - step : step) : 4 + (d ? 259 - step : step - 4);
        const int rowbase = cs < 4 ? NLAT + b * CTXL + 64 * cs : b * SEQ + 64 * (cs - 4);
        bf16x8 Sb[4];
#pragma unroll
        for (int kk = 0; kk < 4; ++kk) Sb[kk] = pack8(S[2 * kk], S[2 * kk + 1]);
        bf16x8 KF[4][4], QF[4][4];
#pragma unroll
        for (int mt = 0; mt < 4; ++mt)
#pragma unroll
            for (int kk = 0; kk < 4; ++kk) { const LAS unsigned char* kp = bf + SC_K + (16 * mt + fr) * 272 + (32 * kk + 4 * g) * 2; const u32x2 klo = *(const LAS u32x2*)kp, khi = *(const LAS u32x2*)(kp + 32);
                KF[mt][kk] = mk8(klo.x, klo.y, khi.x, khi.y); QF[mt][kk] = *(const LAS bf16x8*)(bf + SC_Q + ((mt * 4 + kk) * 64 + lane) * 16); }
        LDS_WAIT();
        f32x4 KS[4], QS[4];
#pragma unroll
        for (int mt = 0; mt < 4; ++mt) { KS[mt] = (f32x4){0.f, 0.f, 0.f, 0.f}; QS[mt] = (f32x4){0.f, 0.f, 0.f, 0.f};
#pragma unroll
            for (int kk = 0; kk < 4; ++kk) { KS[mt] = MFMA16(KF[mt][kk], Sb[kk], KS[mt]); QS[mt] = MFMA16(QF[mt][kk], Sb[kk], QS[mt]); } }
        bf16x8 TF[4][2], GF[4][2]; f32x4 egc[4], ekd[4], bt4[4];
#pragma unroll
        for (int mt = 0; mt < 4; ++mt) { const int to = (16 * mt + 4 * g) * 4;
            bt4[mt] = *(const LAS f32x4*)(bf + SC_AUX + to); egc[mt] = *(const LAS f32x4*)(bf + SC_AUX + 256 + to); ekd[mt] = *(const LAS f32x4*)(bf + SC_AUX + 512 + to);
#pragma unroll
            for (int k2 = 0; k2 < 2; ++k2) { TF[mt][k2] = *(const LAS bf16x8*)(bf + SC_T + ((mt * 2 + k2) * 64 + lane) * 16); GF[mt][k2] = *(const LAS bf16x8*)(bf + SC_QK + ((mt * 2 + k2) * 64 + lane) * 16); } }
        const float egl = *(const LAS float*)(bf + SC_AUX + 768);
        LDS_WAIT();
        f32x4 D[4];
#pragma unroll
        for (int mt = 0; mt < 4; ++mt) { const u32x2 vv = vcur[mt]; const f32x4 v4 = {bflo(vv.x), bfhi(vv.x), bflo(vv.y), bfhi(vv.y)}; D[mt] = bt4[mt] * (v4 - egc[mt] * KS[mt]); }
        bf16x8 Db[2];
#pragma unroll
        for (int k2 = 0; k2 < 2; ++k2) Db[k2] = pack8(D[2 * k2], D[2 * k2 + 1]);
        f32x4 VN[4];
#pragma unroll
        for (int mt = 0; mt < 4; ++mt) { VN[mt] = (f32x4){0.f, 0.f, 0.f, 0.f};
#pragma unroll
            for (int k2 = 0; k2 < 2; ++k2) VN[mt] = MFMA16(TF[mt][k2], Db[k2], VN[mt]); }
        bf16x8 Vb[2], Vd[2];
#pragma unroll
        for (int k2 = 0; k2 < 2; ++k2) { Vb[k2] = pack8(VN[2 * k2], VN[2 * k2 + 1]); Vd[k2] = pack8(ekd[2 * k2] * VN[2 * k2], ekd[2 * k2 + 1] * VN[2 * k2 + 1]); }
        u32x2 t[32];
#pragma unroll
        for (int dt = 0; dt < 8; ++dt)
#pragma unroll
            for (int k2 = 0; k2 < 2; ++k2) { const unsigned ad = ktbase + (32 * k2) * 272 + (16 * dt) * 2; t[(dt * 2 + k2) * 2] = tr_issue(ad); t[(dt * 2 + k2) * 2 + 1] = tr_issue(ad + 16 * 272); }
#pragma unroll
        for (int mt = 0; mt < 4; ++mt) { f32x4 O = egc[mt] * QS[mt] * 0.08838834764831845f;
#pragma unroll
            for (int k2 = 0; k2 < 2; ++k2) O = MFMA16(GF[mt][k2], Vb[k2], O);
            bf16* op = obuf + (size_t)(rowbase + 16 * mt + 4 * g) * 512 + h * 128 + 16 * s + fr;
#pragma unroll
            for (int r = 0; r < 4; ++r) op[r * 512] = f2bf(O[r]); }
        tr_wait8(t[0], t[1], t[2], t[3], t[4], t[5], t[6], t[7]); tr_wait8(t[8], t[9], t[10], t[11], t[12], t[13], t[14], t[15]);
        tr_wait8(t[16], t[17], t[18], t[19], t[20], t[21], t[22], t[23]); tr_wait8(t[24], t[25], t[26], t[27], t[28], t[29], t[30], t[31]);
#pragma unroll
        for (int dt = 0; dt < 8; ++dt) { f32x4 acc = S[dt] * egl;
#pragma unroll
            for (int k2 = 0; k2 < 2; ++k2) acc = MFMA16(mk8(t[(dt * 2 + k2) * 2].x, t[(dt * 2 + k2) * 2].y, t[(dt * 2 + k2) * 2 + 1].x, t[(dt * 2 + k2) * 2 + 1].y), Vd[k2], acc);
            S[dt] = acc; }
#pragma unroll
        for (int mt = 0; mt < 4; ++mt) vcur[mt] = vnxt[mt];
        }
        if (wave >= 2) { if (step + 2 < 260) { if (wave < 4) asm volatile("s_waitcnt vmcnt(9)" ::: "memory"); else asm volatile("s_waitcnt vmcnt(8)" ::: "memory"); } else VM_WAIT(); }
        LDS_WAIT(); __builtin_amdgcn_s_barrier(); asm volatile("" ::: "memory");
        bsel = bsel == 2 ? 0 : bsel + 1;
    }
}

template <bool CTXQ> __device__ __forceinline__ void na_wave(const Args& a, int item, LAS unsigned char* lds, int lane) {
    const unsigned char* ws = a.ws; const int fr = lane & 15, g = lane >> 4;
    const bf16* na = (const bf16*)(ws + WS_NA); const bf16* vt = (const bf16*)(ws + WS_VT); bf16* mix = (bf16*)(ws + WS_QKV);
    int b, h, r = 0, wq = 0, qrow, r0 = 0, cw0 = 0;
    if (CTXQ) { const int qb = item & 15; h = (item >> 4) & 3; b = item >> 6; qrow = NLAT + b * CTXL + 16 * qb + fr; }
    else { wq = item & 3; r = (item >> 2) & 255; h = (item >> 10) & 3; b = item >> 12; qrow = b * SEQ + 64 * r + 16 * wq + fr;
        r0 = min(max(r - 4, 0), 248); cw0 = min(max(16 * wq - 8, 0), 32); }
    bf16x8 qf[2];
#pragma unroll
    for (int kk = 0; kk < 2; ++kk) qf[kk] = *(const bf16x8*)(na + (size_t)qrow * 768 + h * 64 + 32 * kk + 8 * g);
    constexpr int NT = CTXQ ? 16 : 32, T0 = CTXQ ? 16 : 0;
    f32x4 sc[NT];
#pragma unroll
    for (int t = 0; t < NT; ++t) { const int T = T0 + t;
        const int krow = T < 16 ? b * SEQ + (r0 + (T >> 1)) * 64 + cw0 + 16 * (T & 1) + fr : NLAT + b * CTXL + 16 * (T - 16) + fr;
        f32x4 acc = {0.f, 0.f, 0.f, 0.f};
#pragma unroll
        for (int kk = 0; kk < 2; ++kk) acc = MFMA16(*(const bf16x8*)(na + (size_t)krow * 768 + 256 + h * 64 + 32 * kk + 8 * g), qf[kk], acc);
        sc[t] = acc * (0.125f * LOG2E); if ((t & 3) == 3) __builtin_amdgcn_sched_barrier(0); }
    float mx = -3.0e38f;
    if (!CTXQ) { const LAS float* rpb = (const LAS float*)(lds + SC_RPB) + h * 465; const int qcol = 16 * wq + fr, c0 = min(max(qcol - 8, 0), 48);
#pragma unroll
        for (int t = 0; t < 16; ++t) { const int offr = r0 + (t >> 1) - r + 7;
#pragma unroll
            for (int j = 0; j < 4; ++j) { const int kc = cw0 + 16 * (t & 1) + 4 * g + j; const bool ok = kc >= c0 && kc < c0 + 16; const int offc = min(max(kc - qcol + 15, 0), 30);
                sc[t][j] = ok ? sc[t][j] + rpb[offr * 31 + offc] : -3.0e38f; } } }
#pragma unroll
    for (int t = 0; t < NT; ++t) mx = fmaxf(fmaxf(fmaxf(sc[t][0], sc[t][1]), fmaxf(sc[t][2], sc[t][3])), mx);
    mx = fmaxf(mx, __shfl_xor(mx, 16)); mx = fmaxf(mx, __shfl_xor(mx, 32));
    float sum = 0.f;
#pragma unroll
    for (int t = 0; t < NT; ++t)
#pragma unroll
        for (int j = 0; j < 4; ++j) { const float p = exp2f(sc[t][j] - mx); sc[t][j] = p; sum += p; }
    sum += __shfl_xor(sum, 16); sum += __shfl_xor(sum, 32);
    const float inv = 1.0f / sum;
    f32x4 O[4];
#pragma unroll
    for (int mt = 0; mt < 4; ++mt) O[mt] = (f32x4){0.f, 0.f, 0.f, 0.f};
    const bf16* vbase = vt + ((size_t)(b * 4 + h) * 64 + fr) * 16640;
#pragma unroll
    for (int k2 = 0; k2 < NT / 2; ++k2) { const int T = T0 + 2 * k2;
        const int tp = T < 16 ? (r0 + (T >> 1)) * 64 + cw0 + 4 * g : 16384 + 16 * (T - 16) + 4 * g;
        const bf16x8 pb = pack8(sc[2 * k2] * inv, sc[2 * k2 + 1] * inv);
#pragma unroll
        for (int mt = 0; mt < 4; ++mt) { const bf16* vp = vbase + (size_t)(16 * mt) * 16640 + tp; const u32x2 lo = *(const u32x2*)vp, hi = *(const u32x2*)(vp + 16);
            O[mt] = MFMA16(mk8(lo.x, lo.y, hi.x, hi.y), pb, O[mt]); } if ((k2 & 1) == 1) __builtin_amdgcn_sched_barrier(0); }
#pragma unroll
    for (int mt = 0; mt < 4; ++mt) { const f32x4 o = O[mt];
        *(u32x2*)(mix + (size_t)qrow * 1024 + 512 + h * 64 + 16 * mt + 4 * g) = (u32x2){pk2(o[0], o[1]), pk2(o[2], o[3])}; }
}
__device__ __forceinline__ void dn_combine(const Args& a, int l, int gw, int ngw, int lane) {
    unsigned char* ws = a.ws; const int nrow = l == 0 ? NROW : NLAT;
    const bf16* of = (const bf16*)(ws + WS_HBUF); const bf16* ob = of + (size_t)NROW * 512; const bf16* zb = (const bf16*)(ws + WS_Z); bf16* mix = (bf16*)(ws + WS_QKV);
    const float* nw = a.in[12] + l * 128 + (8 * lane & 127);
    float w[8];
#pragma unroll
    for (int e = 0; e < 8; ++e) w[e] = nw[e];
    for (int row = gw; row < nrow; row += ngw) {
        const u32x4 pf = *(const u32x4*)(of + (size_t)row * 512 + 8 * lane), pb = *(const u32x4*)(ob + (size_t)row * 512 + 8 * lane), pz = *(const u32x4*)(zb + (size_t)row * 512 + 8 * lane);
        const unsigned f[4] = {pf.x, pf.y, pf.z, pf.w}, bb[4] = {pb.x, pb.y, pb.z, pb.w}, zz[4] = {pz.x, pz.y, pz.z, pz.w};
        float o[8], ss = 0.f;
#pragma unroll
        for (int e = 0; e < 4; ++e) { o[2 * e] = bflo(f[e]) + bflo(bb[e]); o[2 * e + 1] = bfhi(f[e]) + bfhi(bb[e]); ss += o[2 * e] * o[2 * e] + o[2 * e + 1] * o[2 * e + 1]; }
        ss += __shfl_xor(ss, 1); ss += __shfl_xor(ss, 2); ss += __shfl_xor(ss, 4); ss += __shfl_xor(ss, 8);
        const float rinv = rsqrtf(ss * (1.0f / 128.0f) + EPS);
        unsigned ow[4];
#pragma unroll
        for (int e = 0; e < 4; ++e) ow[e] = pk2(o[2 * e] * rinv * w[2 * e] * silu_f(bflo(zz[e])), o[2 * e + 1] * rinv * w[2 * e + 1] * silu_f(bfhi(zz[e])));
        *(u32x4*)(mix + (size_t)row * 1024 + 8 * lane) = (u32x4){ow[0], ow[1], ow[2], ow[3]};
    }
}
__device__ __forceinline__ void ft_stage2_item(const Args& a, int l, int item, LAS unsigned char* lds, int tid, int wave, int lane) {
    unsigned char* ws = a.ws; const bool isctx = item >= 256; int b, kb;
    const bf16* src; const bf16* amat; float scale; size_t tokbase; int tokstride;
    if (!isctx) { b = item >> 7; kb = item & 127; src = (const bf16*)(ws + WS_Y) + (size_t)(b * 128 + kb) * 65536; amat = (const bf16*)(ws + WS_A2); scale = 1.0f; tokbase = (size_t)b * SEQ + kb; tokstride = 128; }
    else { b = (item - 256) >> 1; kb = (item - 256) & 1; src = (const bf16*)(ws + WS_FT) + (size_t)(NLAT + b * CTXL) * 256; amat = (const bf16*)(ws + WS_A2C) + (size_t)kb * 65536; scale = 8.0f; tokbase = (size_t)NLAT + b * CTXL + 128 * kb; tokstride = 1; }
#pragma unroll
    for (int i = 0; i < 16; ++i) { const int p = tid + 512 * i, row = p >> 5, cp = p & 31; *(LAS u32x4*)(lds + row * 528 + cp * 16) = *(const u32x4*)(src + (size_t)row * 256 + cp * 8); }
    __syncthreads();
    const int fr = lane & 15, g = lane >> 4, q = fr >> 2, pp = fr & 3;
    const unsigned lbase = (unsigned)(size_t)(lds) + (8 * g + q) * 528 + 8 * pp;
    f32x4 Z[16][2];
#pragma unroll
    for (int mt = 0; mt < 16; ++mt) { Z[mt][0] = (f32x4){0.f, 0.f, 0.f, 0.f}; Z[mt][1] = (f32x4){0.f, 0.f, 0.f, 0.f}; }
#pragma unroll 1
    for (int kk = 0; kk < 8; ++kk) {
        const bf16x8 b0 = *(const bf16x8*)(amat + (size_t)(16 * wave + fr) * 256 + 32 * kk + 8 * g), b1 = *(const bf16x8*)(amat + (size_t)(128 + 16 * wave + fr) * 256 + 32 * kk + 8 * g);
#pragma unroll
        for (int mt = 0; mt < 16; ++mt) { const unsigned ad = lbase + 32 * kk * 528 + 32 * mt; const bf16x8 av = lds_tr8(ad, ad + 4 * 528);
            Z[mt][0] = MFMA16(av, b0, Z[mt][0]); Z[mt][1] = MFMA16(av, b1, Z[mt][1]); }
    }
    bf16x8 Zb[16];
#pragma unroll
    for (int k3 = 0; k3 < 16; ++k3) { const int c = k3 >> 3, k2 = k3 & 7; Zb[k3] = pack8(Z[2 * k2][c], Z[2 * k2 + 1][c]); }
    const bf16* wft = (const bf16*)(ws + WS_WFT) + (size_t)l * 131072; bf16* mix = (bf16*)(ws + WS_QKV);
    const size_t tok = tokbase + (size_t)(16 * wave + fr) * tokstride;
#pragma unroll 2
    for (int jt = 0; jt < 16; ++jt) { f32x4 acc = {0.f, 0.f, 0.f, 0.f};
#pragma unroll
        for (int k3 = 0; k3 < 16; ++k3) acc = MFMA16(*(const bf16x8*)(wft + ((size_t)(jt * 16 + k3) * 64 + lane) * 8), Zb[k3], acc);
        acc = acc * scale;
        *(u32x2*)(mix + tok * 1024 + 768 + 16 * jt + 4 * g) = (u32x2){pk2(acc[0], acc[1]), pk2(acc[2], acc[3])}; }
    __syncthreads();
}
__global__ __launch_bounds__(512, 2) void mega(Args a0) {
    extern __shared__ __attribute__((aligned(16))) unsigned char shm[];
    cg::grid_group grid = cg::this_grid();
    const int tid0 = threadIdx.x, blk0 = blockIdx.x, nblk = gridDim.x;
#ifndef REP_PH
#define REP_PH (-1)
#endif
    volatile LAS unsigned* xb_st = (volatile LAS unsigned*)((LAS unsigned char*)shm + LDS_BYTES - 16);
    if (tid0 == 0) { xb_st[0] = 0u; xb_st[1] = 0u; }
    __syncthreads();
    const XcdBarrier xb = xcd_barrier_post((unsigned*)(a0.ws + WS_CTL + 524288), xb_st);
    int ph = 0;
#define PH_BEGIN if (ph >= a0.lo && ph < a0.hi) { if (ph > a0.lo) { if (a0.lo < 0) grid.sync(); xcd_barrier(xb); } \
    int tid = tid0, blk = blk0; asm volatile("" : "+v"(tid)); asm volatile("" : "+s"(blk)); \
    Args a = a0; asm volatile("" : "+s"(a.ws)); asm volatile("" : "+s"(a.out)); \
    LAS unsigned char* lds = (LAS unsigned char*)shm; unsigned char* ws = a.ws; const float* modv = (const float*)(ws + WS_CTL + CTL_MODV); \
    const int wave = __builtin_amdgcn_readfirstlane(tid >> 6), lane = tid & 63; \
    const int gw = blk * 8 + wave, ngw = nblk * 8, gtid = blk * 512 + tid, ngt = nblk * 512; (void)gtid; (void)ngt; (void)gw; (void)ngw; (void)modv; (void)lds; (void)lane;
#define PH_END } ++ph;
#ifndef REPP
#define REPP 1
#endif
    PH_BEGIN { for (int rr = 0; rr < REPP; ++rr) phase_prologue(a, lds, gw, ngw, wave, lane, gtid, ngt); } PH_END
#ifdef XSYNC
    for (int xs = 0; xs < XSYNC; ++xs) { asm volatile("s_waitcnt vmcnt(0) lgkmcnt(0)" ::: "memory"); grid.sync(); __builtin_amdgcn_fence(__ATOMIC_ACQUIRE, "agent"); }
#endif
#pragma unroll 1
    for (int l = 0; l < 2; ++l) {
        PH_BEGIN phase_A(a, l, lds, gw, ngw, tid, lane); PH_END
        PH_BEGIN { pg8::Gemm g{(const pg8::bf16_t*)(ws + WS_HBUF), (const pg8::bf16_t*)(ws + WS_WIN) + (size_t)l * 3072 * 1024, NROW, 3072, 1024};
            pg8::StaticOrder S; S.init(NROW, 3072, nblk, blk); pg8::EpiProj E{ws}; pg8::gemm_phase<pg8::EpiProj, pg8::StaticOrder, false>(lds, g, S, E, nullptr); __syncthreads(); } PH_END
        PH_BEGIN {
#ifndef REPC
#define REPC 1
#endif
#pragma unroll 1
            for (int rr = 0; rr < REPC; ++rr)
            for (int it = blk; it < 2080; it += nblk) dn_prep_item(a, l, it, lds, tid, wave, lane);
            if (blk >= 32) { for (int it = (blk - 32) * 8 + wave; it < 4160; it += 1792) na_prep_item(a, l, it, lane);
                for (int it = blk - 32; it < 256; it += 224) ft_stage1_item(a, it, lds, tid, wave, lane); }
        } PH_END
        PH_BEGIN {
            if (blk < 64) scan_block(a, blk & 15, blk >> 4, lds, wave, lane);
            else { LAS float* rpb = (LAS float*)(lds + SC_RPB);
                for (int i = tid; i < 1860; i += 512) rpb[i] = a.in[15][l * 1860 + i] * LOG2E;
                __syncthreads();
                const int nidx = (blk - 64) * 8 + wave;
#pragma unroll 1
                for (int it = nidx; it < 8192 + 128; it += 1536) { if (it < 8192) na_wave<false>(a, it, lds, lane); else if (l == 0) na_wave<true>(a, it - 8192, lds, lane); }
                __syncthreads();
                const int nft = l == 0 ? 260 : 256;
                for (int it = blk - 64; it < nft; it += 192) ft_stage2_item(a, l, it, lds, tid, wave, lane); }
            __syncthreads();
        } PH_END
        PH_BEGIN {
            dn_combine(a, l, gw, ngw, lane);
        } PH_END
        PH_BEGIN { const int M = l == 0 ? NROW : NLAT;
            pg8::Gemm g{(const pg8::bf16_t*)(ws + WS_QKV), (const pg8::bf16_t*)(ws + WS_WOUT) + (size_t)l * 1024 * 1024, M, 1024, 1024};
            pg8::StaticOrder S; S.init(M, 1024, nblk, blk);
            pg8::EpiResid E{l == 0 ? a.in[0] : a.out, l == 0 ? a.in[2] : (const float*)(ws + WS_CTXS), a.out, (float*)(ws + WS_CTXS), modv + (size_t)l * 3 * 6144 + 2048};
            pg8::gemm_phase<pg8::EpiResid, pg8::StaticOrder, false>(lds, g, S, E, nullptr); __syncthreads(); } PH_END
#ifndef REPM
#define REPM 1
#endif
        PH_BEGIN { phase_F(a, l, lds, gw, ngw, tid, lane); if (l == 1) for (int rr = 0; rr < REPM; ++rr) phase_moe_convert(a, lds, gw, ngw, wave, lane); } PH_END
        if (l == 0) {
            PH_BEGIN { pg8::Gemm g{(const pg8::bf16_t*)(ws + WS_HBUF), (const pg8::bf16_t*)(ws + WS_W13), NROW, 5632, 1024};
                pg8::StaticOrder S; S.init(NROW, 5632, nblk, blk); pg8::EpiSwiglu E{(pg8::bf16_t*)(ws + WS_ACT), DFF, 0};
                pg8::gemm_phase<pg8::EpiSwiglu, pg8::StaticOrder, false>(lds, g, S, E, nullptr); __syncthreads(); } PH_END
            PH_BEGIN { pg8::Gemm g{(const pg8::bf16_t*)(ws + WS_ACT), (const pg8::bf16_t*)(ws + WS_W2), NROW, 1024, DFF};
                pg8::StaticOrder S; S.init(NROW, 1024, nblk, blk);
                pg8::EpiResid E{a.out, (const float*)(ws + WS_CTXS), a.out, (float*)(ws + WS_CTXS), modv + 5120};
                pg8::gemm_phase<pg8::EpiResid, pg8::StaticOrder, false>(lds, g, S, E, nullptr); __syncthreads(); } PH_END
        } else {
            PH_BEGIN phase_moe_assign(a, gw, lane); PH_END
            {
                int ps[9]; moe_pads(a0.ws, ps);
                const int nbt = ps[8] >> 8;
#pragma unroll 1
                for (int c0 = 0; c0 < nbt; c0 += MACT_ROWS / 256) {
                    const int nM = nbt - c0 < MACT_ROWS / 256 ? nbt - c0 : MACT_ROWS / 256;
                    PH_BEGIN { pg8::Gemm g{(const pg8::bf16_t*)(ws + WS_XB), (const pg8::bf16_t*)(ws + WS_MW13), 0, 7168, 1024};
                        pg8::MoeOrder S{nM, 28, c0, nblk, blk, {ps[0], ps[1], ps[2], ps[3], ps[4], ps[5], ps[6], ps[7]}, (size_t)7168 * 1024 * 2}; pg8::EpiSwiglu E{(pg8::bf16_t*)(ws + WS_MACT), DFFE, c0 * 256};
                        pg8::gemm_phase<pg8::EpiSwiglu, pg8::MoeOrder, false>(lds, g, S, E, nullptr); __syncthreads(); } PH_END
                    PH_BEGIN { pg8::Gemm g{(const pg8::bf16_t*)(ws + WS_MACT) - (size_t)c0 * 256 * DFFE, (const pg8::bf16_t*)(ws + WS_MW2), 0, 1024, DFFE};
                        pg8::MoeOrder S{nM, 4, c0, nblk, blk, {ps[0], ps[1], ps[2], ps[3], ps[4], ps[5], ps[6], ps[7]}, (size_t)1024 * DFFE * 2}; pg8::EpiBf16Out E{(pg8::bf16_t*)(ws + WS_XB), 1024};
                        pg8::gemm_phase<pg8::EpiBf16Out, pg8::MoeOrder, false>(lds, g, S, E, nullptr); __syncthreads(); } PH_END
                }
            }
            PH_BEGIN phase_moe_combine(a, gw, ngw, lane); PH_END
        }
    }
#ifdef DBG_SRC
    __builtin_amdgcn_fence(__ATOMIC_RELEASE, "agent"); grid.sync(); __builtin_amdgcn_fence(__ATOMIC_ACQUIRE, "agent");
    { const size_t n = (size_t)NLAT * 1024; const size_t gt = (size_t)blk0 * 512 + tid0, ng = (size_t)nblk * 512;
      if (DBG_KIND == 0) { const bf16* src = (const bf16*)(a0.ws + (size_t)DBG_SRC); for (size_t i = gt; i < n; i += ng) { a0.out[i] = (float)(src[i] & 7); } }
      else { const float* src = (const float*)(a0.ws + (size_t)DBG_SRC); for (size_t i = gt; i < n; i += ng) a0.out[i] = src[i % (size_t)DBG_N]; } }
#endif
}
constexpr int N_PHASES = 1 + 9 + 7 + 1 + 16 + 1;
#ifndef DBG_HI
#define DBG_HI (1 << 30)
#endif

extern "C" void kernel_launch(void* const* d_in, const int* in_sizes, int n_in, void* d_out, int out_size, void* d_ws, size_t ws_size, hipStream_t stream) {
    static int inited = 0;
    if (!inited) {
        if (hipFuncSetAttribute((const void*)mega, hipFuncAttributeMaxDynamicSharedMemorySize, LDS_BYTES) != hipSuccess) fprintf(stderr, "kernel_launch: hipFuncSetAttribute failed\n");
        inited = 1;
    }
    (void)hipMemsetAsync((char*)d_ws + WS_CTL, 0, 1048576, stream);
    Args a{};
    for (int i = 0; i < 25; ++i) a.in[i] = (const float*)d_in[i];
    a.out = (float*)d_out; a.ws = (unsigned char*)d_ws; a.lo = 0; a.hi = DBG_HI;
#ifdef MULTI_LAUNCH
    for (int p = 0; p < DBG_HI; p += MULTI_LAUNCH) { a.lo = p; a.hi = p + MULTI_LAUNCH < DBG_HI ? p + MULTI_LAUNCH : DBG_HI;
        void* args[] = {&a};
        hipError_t e = hipLaunchCooperativeKernel((const void*)mega, dim3(256), dim3(512), args, LDS_BYTES, stream);
        if (e != hipSuccess) { fprintf(stderr, "kernel_launch: cooperative launch failed: %s\n", hipGetErrorString(e)); break; } }
#else
    void* args[] = {&a};
    hipError_t e = hipLaunchCooperativeKernel((const void*)mega, dim3(256), dim3(512), args, LDS_BYTES, stream);
    if (e != hipSuccess) fprintf(stderr, "kernel_launch: cooperative launch failed: %s\n", hipGetErrorString(e));
#endif
}
```
